# Optimizing an MI355X kernel written in HIP

```python
import math
import jax
import jax.numpy as jnp
from jax import lax
import numpy as np

D_MODEL = 1024
BATCH = 8
SEQ = 2048
DEPTH = 2

CTX_LEN = 256
GRID_W = 64
MIX_WIDTH = D_MODEL
LRU_WIDTH = MIX_WIDTH // 2
LRU_BLOCK = 64
LRU_HEADS = LRU_WIDTH // LRU_BLOCK
LRU_C = 8.0
SSD_INNER = MIX_WIDTH - LRU_WIDTH
SSD_HEAD_DIM = 64
SSD_HEADS = SSD_INNER // SSD_HEAD_DIM
SSD_GROUPS = 2
SSD_HPG = SSD_HEADS // SSD_GROUPS
SSD_STATE = 128
SSD_CHUNK = 128
SSD_XBC = SSD_INNER + 2 * SSD_GROUPS * SSD_STATE
SSD_DT = 2 * SSD_HEADS
CONV_K = 4
CONV_LEFT = 1
D_FF = 4 * D_MODEL
N_SCAN_COLS = LRU_WIDTH + SSD_XBC + SSD_DT
N_IN_COLS = N_SCAN_COLS + LRU_WIDTH + SSD_INNER
N_MOD = 6
EPS = 1e-6

kernel_name = 'hybrid_rglru_ssd_prefix_dit_block'


def _rmsnorm(x, g):
    xf = x.astype(jnp.float32)
    y = xf * lax.rsqrt(jnp.mean(xf * xf, axis=-1, keepdims=True) + EPS)
    return (y * g.astype(jnp.float32)).astype(x.dtype)


def _modulate(h, shift, scale):
    return h * (1.0 + scale) + shift


def _sq_relu_mlp(h, w1, w2):
    return jnp.square(jax.nn.relu(h @ w1)) @ w2


def _dwconv(u, w, b):
    y = lax.conv_general_dilated(
        u, w[:, None, :].astype(u.dtype), window_strides=(1,),
        padding=[(CONV_LEFT, CONV_K - 1 - CONV_LEFT)],
        dimension_numbers=('NWC', 'WIO', 'NWC'), feature_group_count=u.shape[-1])
    return y + b.astype(u.dtype)


def _to_col_major(t, rows):
    b, l, ch = t.shape
    return t.reshape(b, rows, GRID_W, ch).swapaxes(1, 2).reshape(b, l, ch)


def _from_col_major(t, rows):
    b, l, ch = t.shape
    return t.reshape(b, GRID_W, rows, ch).swapaxes(1, 2).reshape(b, l, ch)


def _flip(t, d):
    return jnp.flip(t, axis=1) if d else t


def _compose(left, right):
    return left[0] * right[0], right[0] * left[1] + right[1]


def _linear_scan(a, b, h0):
    a_cum, h = lax.associative_scan(_compose, (a, b), axis=1)
    if h0 is None:
        return h
    return h + a_cum * h0[:, None]


def _lru_coeffs(u, wa, ba, wx, bx, lam):
    bsz, ln, _ = u.shape
    uf = u.astype(jnp.float32)
    ub = uf.reshape(bsz, ln, LRU_HEADS, LRU_BLOCK)
    r = jax.nn.sigmoid(jnp.einsum('blhi,hij->blhj', ub, wa.astype(jnp.float32)).reshape(bsz, ln, LRU_WIDTH) + ba.astype(jnp.float32))
    i = jax.nn.sigmoid(jnp.einsum('blhi,hij->blhj', ub, wx.astype(jnp.float32)).reshape(bsz, ln, LRU_WIDTH) + bx.astype(jnp.float32))
    log_a = -LRU_C * r * jax.nn.softplus(-lam.astype(jnp.float32))
    return jnp.exp(log_a), jnp.sqrt(-jnp.expm1(2.0 * log_a)) * (i * uf)


def _rglru_bidir(u_ctx, u_lat, wa, ba, wx, bx, lam, need_ctx_out):
    ys_ctx, ys_lat = [], []
    for d in range(2):
        a, b = _lru_coeffs(_flip(u_ctx, d), wa[d], ba[d], wx[d], bx[d], lam[d])
        h_ctx = _linear_scan(a, b, None)
        a, b = _lru_coeffs(_flip(u_lat, d), wa[d], ba[d], wx[d], bx[d], lam[d])
        h_lat = _linear_scan(a, b, h_ctx[:, -1])
        ys_lat.append(_flip(h_lat, d))
        if need_ctx_out:
            ys_ctx.append(_flip(h_ctx, d))
    y_ctx = ys_ctx[0] + ys_ctx[1] if need_ctx_out else None
    return y_ctx, ys_lat[0] + ys_lat[1]


def _ssd_chunked(x, log_a, bm, cm, h0, want_y, want_final):
    bsz, ln = x.shape[0], x.shape[1]
    nc = ln // SSD_CHUNK
    X = x.reshape(bsz, nc, SSD_CHUNK, SSD_GROUPS, SSD_HPG, SSD_HEAD_DIM)
    A = log_a.reshape(bsz, nc, SSD_CHUNK, SSD_GROUPS, SSD_HPG)
    Bc = bm.reshape(bsz, nc, SSD_CHUNK, SSD_GROUPS, SSD_STATE)
    Cc = cm.reshape(bsz, nc, SSD_CHUNK, SSD_GROUPS, SSD_STATE)
    a_cs = jnp.cumsum(A, axis=2)
    a_last = a_cs[:, :, -1]
    states = jnp.einsum('bclgn,bclge,bclgep->bcgepn', Bc, jnp.exp(a_last[:, :, None] - a_cs), X)
    chunk_cum = jnp.cumsum(jnp.pad(a_last, ((0, 0), (1, 0), (0, 0), (0, 0))), axis=1)
    row_idx = np.arange(0 if want_y else nc, nc + 1 if want_final else nc)
    if h0 is None:
        col_idx = np.arange(1, nc + 1)
        states_all = states
    else:
        col_idx = np.arange(0, nc + 1)
        h0g = h0.reshape(bsz, SSD_GROUPS, SSD_HPG, SSD_HEAD_DIM, SSD_STATE)
        states_all = jnp.concatenate([h0g[:, None], states], axis=1)
    seg = chunk_cum[:, row_idx][:, :, None] - chunk_cum[:, col_idx][:, None, :]
    cmask = (row_idx[:, None] >= col_idx[None, :])[None, :, :, None, None]
    decay_chunk = jnp.exp(jnp.where(cmask, seg, -jnp.inf))
    new_states = jnp.einsum('bzkge,bkgepn->bzgepn', decay_chunk, states_all)
    final = new_states[:, -1].reshape(bsz, SSD_HEADS, SSD_HEAD_DIM, SSD_STATE) if want_final else None
    y = None
    if want_y:
        prev = new_states[:, :nc]
        seg_in = a_cs[:, :, :, None] - a_cs[:, :, None, :]
        tri = np.tril(np.ones((SSD_CHUNK, SSD_CHUNK), dtype=bool))[None, None, :, :, None, None]
        l_mat = jnp.exp(jnp.where(tri, seg_in, -jnp.inf))
        cb = jnp.einsum('bclgn,bcsgn->bclsg', Cc, Bc)
        y_diag = jnp.einsum('bclsg,bclsge,bcsgep->bclgep', cb, l_mat, X)
        y_off = jnp.einsum('bclgn,bcgepn,bclge->bclgep', Cc, prev, jnp.exp(a_cs))
        y = (y_diag + y_off).reshape(bsz, ln, SSD_HEADS, SSD_HEAD_DIM)
    return y, final


def _ssd_unpack(xbc, dtr):
    bsz, ln, _ = xbc.shape
    xs, bm, cm = jnp.split(xbc.astype(jnp.float32), [SSD_INNER, SSD_INNER + SSD_GROUPS * SSD_STATE], axis=-1)
    return (xs.reshape(bsz, ln, SSD_HEADS, SSD_HEAD_DIM),
            bm.reshape(bsz, ln, SSD_GROUPS, SSD_STATE),
            cm.reshape(bsz, ln, SSD_GROUPS, SSD_STATE),
            dtr.astype(jnp.float32).reshape(bsz, ln, 2, SSD_HEADS))


def _ssd_bidir(xbc_c, dt_c, xbc_l, dt_l, dt_bias, a_log, d_skip, need_ctx_out):
    xs_c, b_c, cm_c, dtr_c = _ssd_unpack(xbc_c, dt_c)
    xs_l, b_l, cm_l, dtr_l = _ssd_unpack(xbc_l, dt_l)

    def drive(xs, dtr, d):
        dt = jax.nn.softplus(dtr[:, :, d] + dt_bias[d].astype(jnp.float32))
        return xs * dt[..., None], dt * (-jnp.exp(a_log[d].astype(jnp.float32)))

    ys_ctx, ys_lat = [], []
    for d in range(2):
        xc, ac = drive(xs_c, dtr_c, d)
        yc, hc = _ssd_chunked(_flip(xc, d), _flip(ac, d), _flip(b_c, d), _flip(cm_c, d), None, need_ctx_out, True)
        xl, al = drive(xs_l, dtr_l, d)
        yl, _ = _ssd_chunked(_flip(xl, d), _flip(al, d), _flip(b_l, d), _flip(cm_l, d), hc, True, False)
        ys_lat.append(_flip(yl, d))
        if need_ctx_out:
            ys_ctx.append(_flip(yc, d))
    skip = d_skip.astype(jnp.float32)[:, None]
    y_lat = ys_lat[0] + ys_lat[1] + skip * xs_l
    y_ctx = ys_ctx[0] + ys_ctx[1] + skip * xs_c if need_ctx_out else None
    return y_ctx, y_lat


def _gated_group_rmsnorm(y, z, g):
    yf = y * jax.nn.silu(z.astype(jnp.float32))
    b, l, w = yf.shape
    yg = yf.reshape(b, l, SSD_GROUPS, w // SSD_GROUPS)
    yg = yg * lax.rsqrt(jnp.mean(yg * yg, axis=-1, keepdims=True) + EPS)
    return yg.reshape(b, l, w) * g.astype(jnp.float32)


def _mixer(h_lat, h_ctx, w_in, lru_conv_w, lru_conv_b, lru_wa, lru_ba, lru_wx, lru_bx, lru_lambda,
           ssd_conv_w, ssd_conv_b, ssd_dt_bias, ssd_a_log, ssd_d, ssd_norm_g, w_out, need_ctx_out):
    bsz, n_lat, _ = h_lat.shape
    rows = n_lat // GRID_W
    splits = [LRU_WIDTH, LRU_WIDTH + SSD_XBC, N_SCAN_COLS, N_SCAN_COLS + LRU_WIDTH]
    lx_l, xbc_l, dt_l, lg_l, z_l = jnp.split(h_lat @ w_in, splits, axis=-1)
    if need_ctx_out:
        lx_c, xbc_c, dt_c, lg_c, z_c = jnp.split(h_ctx @ w_in, splits, axis=-1)
    else:
        lx_c, xbc_c, dt_c = jnp.split(h_ctx @ w_in[:, :N_SCAN_COLS], splits[:2], axis=-1)

    lru_c, lru_l = _rglru_bidir(_dwconv(lx_c, lru_conv_w, lru_conv_b), _dwconv(lx_l, lru_conv_w, lru_conv_b),
                                lru_wa, lru_ba, lru_wx, lru_bx, lru_lambda, need_ctx_out)

    xbc_l = jax.nn.silu(_dwconv(_to_col_major(xbc_l, rows), ssd_conv_w, ssd_conv_b))
    xbc_c = jax.nn.silu(_dwconv(xbc_c, ssd_conv_w, ssd_conv_b))
    ssd_c, ssd_l = _ssd_bidir(xbc_c, dt_c, xbc_l, _to_col_major(dt_l, rows),
                              ssd_dt_bias, ssd_a_log, ssd_d, need_ctx_out)
    ssd_l = _from_col_major(ssd_l.reshape(bsz, n_lat, SSD_INNER), rows)

    cat_l = jnp.concatenate([lru_l * jax.nn.gelu(lg_l.astype(jnp.float32)),
                             _gated_group_rmsnorm(ssd_l, z_l, ssd_norm_g)], axis=-1)
    out_l = cat_l.astype(h_lat.dtype) @ w_out
    out_c = None
    if need_ctx_out:
        ssd_c = ssd_c.reshape(bsz, h_ctx.shape[1], SSD_INNER)
        cat_c = jnp.concatenate([lru_c * jax.nn.gelu(lg_c.astype(jnp.float32)),
                                 _gated_group_rmsnorm(ssd_c, z_c, ssd_norm_g)], axis=-1)
        out_c = cat_c.astype(h_ctx.dtype) @ w_out
    return out_l, out_c


def setup_inputs(seed: int = 0) -> dict:
    key = jax.random.key(seed)
    ks = jax.random.split(key, 32)

    def nrm(k, shape, scale):
        return jax.random.normal(k, shape, jnp.float32) * scale

    x = nrm(ks[0], (BATCH, SEQ, D_MODEL), 1.0)
    c = nrm(ks[1], (BATCH, D_MODEL), 1.0)
    ctx = nrm(ks[2], (BATCH, CTX_LEN, D_MODEL), 1.0)
    c_ctx = nrm(ks[3], (D_MODEL,), 1.0)
    ada_w = nrm(ks[4], (DEPTH, D_MODEL, N_MOD * D_MODEL), 0.5 * D_MODEL ** -0.5)
    ada_b = nrm(ks[5], (DEPTH, N_MOD * D_MODEL), 0.01)
    norm1_g = 1.0 + nrm(ks[6], (DEPTH, D_MODEL), 0.1)
    norm2_g = 1.0 + nrm(ks[7], (DEPTH, D_MODEL), 0.1)
    w_in = nrm(ks[8], (DEPTH, D_MODEL, N_IN_COLS), D_MODEL ** -0.5)
    lru_conv_w = nrm(ks[9], (DEPTH, CONV_K, LRU_WIDTH), CONV_K ** -0.5)
    lru_conv_b = nrm(ks[10], (DEPTH, LRU_WIDTH), 0.01)
    lru_wa = nrm(ks[11], (DEPTH, 2, LRU_HEADS, LRU_BLOCK, LRU_BLOCK), LRU_BLOCK ** -0.5)
    lru_ba = nrm(ks[12], (DEPTH, 2, LRU_WIDTH), 0.01)
    lru_wx = nrm(ks[13], (DEPTH, 2, LRU_HEADS, LRU_BLOCK, LRU_BLOCK), LRU_BLOCK ** -0.5)
    lru_bx = nrm(ks[14], (DEPTH, 2, LRU_WIDTH), 0.01)
    a_pow_c = jax.random.uniform(ks[15], (DEPTH, 2, LRU_WIDTH), jnp.float32, 0.9, 0.999)
    log_a = jnp.log(a_pow_c) / LRU_C
    lru_lambda = log_a - jnp.log(-jnp.expm1(log_a))
    ssd_conv_w = nrm(ks[16], (DEPTH, CONV_K, SSD_XBC), CONV_K ** -0.5)
    ssd_conv_b = nrm(ks[17], (DEPTH, SSD_XBC), 0.01)
    dt0 = jnp.exp(jax.random.uniform(ks[18], (DEPTH, 2, SSD_HEADS), jnp.float32, math.log(1e-3), math.log(1e-1)))
    ssd_dt_bias = dt0 + jnp.log(-jnp.expm1(-dt0))
    ssd_a_log = jnp.log(jax.random.uniform(ks[19], (DEPTH, 2, SSD_HEADS), jnp.float32, 1.0, 16.0))
    ssd_d = 1.0 + nrm(ks[20], (DEPTH, SSD_HEADS), 0.1)
    ssd_norm_g = 1.0 + nrm(ks[21], (DEPTH, SSD_INNER), 0.1)
    w_out = nrm(ks[22], (DEPTH, MIX_WIDTH, D_MODEL), MIX_WIDTH ** -0.5)
    mlp_w1 = nrm(ks[23], (DEPTH, D_MODEL, D_FF), D_MODEL ** -0.5)
    mlp_w2 = nrm(ks[24], (DEPTH, D_FF, D_MODEL), D_FF ** -0.5)
    final_g = 1.0 + nrm(ks[25], (D_MODEL,), 0.1)
    return {'x': x, 'c': c, 'ctx': ctx, 'c_ctx': c_ctx, 'ada_w': ada_w, 'ada_b': ada_b,
            'norm1_g': norm1_g, 'norm2_g': norm2_g, 'w_in': w_in,
            'lru_conv_w': lru_conv_w, 'lru_conv_b': lru_conv_b, 'lru_wa': lru_wa, 'lru_ba': lru_ba,
            'lru_wx': lru_wx, 'lru_bx': lru_bx, 'lru_lambda': lru_lambda,
            'ssd_conv_w': ssd_conv_w, 'ssd_conv_b': ssd_conv_b, 'ssd_dt_bias': ssd_dt_bias,
            'ssd_a_log': ssd_a_log, 'ssd_d': ssd_d, 'ssd_norm_g': ssd_norm_g,
            'w_out': w_out, 'mlp_w1': mlp_w1, 'mlp_w2': mlp_w2, 'final_g': final_g}


def reference(x, c, ctx, c_ctx, ada_w, ada_b, norm1_g, norm2_g, w_in,
              lru_conv_w, lru_conv_b, lru_wa, lru_ba, lru_wx, lru_bx, lru_lambda,
              ssd_conv_w, ssd_conv_b, ssd_dt_bias, ssd_a_log, ssd_d, ssd_norm_g,
              w_out, mlp_w1, mlp_w2, final_g):
    silu_c = jax.nn.silu(c)
    silu_cc = jax.nn.silu(c_ctx)
    for l in range(DEPTH):
        need_ctx_out = l < DEPTH - 1
        mod = silu_c @ ada_w[l] + ada_b[l]
        sh1, sc1, g1, sh2, sc2, g2 = jnp.split(mod[:, None, :], N_MOD, axis=-1)
        csh1, csc1, cg1, csh2, csc2, cg2 = jnp.split(silu_cc @ ada_w[l] + ada_b[l], N_MOD, axis=-1)
        h_lat = _modulate(_rmsnorm(x, norm1_g[l]), sh1, sc1)
        h_ctx = _modulate(_rmsnorm(ctx, norm1_g[l]), csh1, csc1)
        y_lat, y_ctx = _mixer(h_lat, h_ctx, w_in[l], lru_conv_w[l], lru_conv_b[l], lru_wa[l], lru_ba[l],
                              lru_wx[l], lru_bx[l], lru_lambda[l], ssd_conv_w[l], ssd_conv_b[l],
                              ssd_dt_bias[l], ssd_a_log[l], ssd_d[l], ssd_norm_g[l], w_out[l], need_ctx_out)
        x = x + g1 * y_lat
        x = x + g2 * _sq_relu_mlp(_modulate(_rmsnorm(x, norm2_g[l]), sh2, sc2), mlp_w1[l], mlp_w2[l])
        if need_ctx_out:
            ctx = ctx + cg1 * y_ctx
            ctx = ctx + cg2 * _sq_relu_mlp(_modulate(_rmsnorm(ctx, norm2_g[l]), csh2, csc2), mlp_w1[l], mlp_w2[l])
    return _rmsnorm(x, final_g)
```

```cpp
#include <hip/hip_runtime.h>
#include <hip/hip_cooperative_groups.h>
#include <cstdio>
namespace cg = cooperative_groups;

#ifndef ONE_LAUNCH
#define ONE_LAUNCH 1
#endif

#define LAS __attribute__((address_space(3)))
typedef unsigned short bf16_t;
typedef short bf16x8 __attribute__((ext_vector_type(8)));
typedef float f32x4 __attribute__((ext_vector_type(4)));
typedef float f32x2 __attribute__((ext_vector_type(2)));
typedef unsigned u32x4 __attribute__((ext_vector_type(4)));
typedef unsigned u32x2 __attribute__((ext_vector_type(2)));
typedef LAS unsigned char* lptr;

constexpr int D = 1024, NLAT = 16384, NCTXR = 2048, NROW = 18432, NPROJ = 2560, DFF = 4096;
constexpr int NTHREADS = 512;
constexpr int LDS_BYTES = 131072;
constexpr float EPS = 1e-6f;
enum { I_X = 0, I_C, I_CTX, I_CCTX, I_ADAW, I_ADAB, I_N1G, I_N2G, I_WIN, I_LCW, I_LCB, I_LWA, I_LBA, I_LWX, I_LBX, I_LLAM,
       I_SCW, I_SCB, I_SDTB, I_SALOG, I_SD, I_SNG, I_WOUT, I_W1, I_W2, I_FG };

constexpr size_t WT_LAYER = 24117248ull;
constexpr size_t WT_WIN = 0, WT_WOUT = 5242880ull, WT_W1 = 7340032ull, WT_W2 = 15728640ull;
constexpr size_t WS_WT = 0;
constexpr size_t WS_MOD = 48234496ull;
constexpr size_t WS_CTX = 48676864ull;
constexpr size_t WS_H = 57065472ull;
constexpr size_t WS_PROJ = 94814208ull;
constexpr size_t WS_YD = 189186048ull;
constexpr size_t YD_ONE = 18874368ull;
constexpr size_t WS_DT = 264683520ull;
constexpr size_t WS_END = 265863168ull;
constexpr size_t WS_HID = WS_PROJ;

struct Args { const float* in[26]; float* out; unsigned char* ws; int ph_lo, ph_hi; };

__device__ __forceinline__ unsigned pk_bf16(float lo, float hi) { unsigned r; asm("v_cvt_pk_bf16_f32 %0, %1, %2" : "=v"(r) : "v"(lo), "v"(hi)); return r; }
__device__ __forceinline__ bf16_t to_bf16(float x) { return (bf16_t)(pk_bf16(x, 0.f) & 0xffffu); }
__device__ __forceinline__ float bf_lo(unsigned w) { return __uint_as_float(w << 16); }
__device__ __forceinline__ float bf_hi(unsigned w) { return __uint_as_float(w & 0xffff0000u); }
__device__ __forceinline__ float bf1(bf16_t h) { return __uint_as_float(((unsigned)h) << 16); }
__device__ __forceinline__ void unpack8(const u32x4 v, float (&f)[8]) {
    f[0] = bf_lo(v.x); f[1] = bf_hi(v.x); f[2] = bf_lo(v.y); f[3] = bf_hi(v.y);
    f[4] = bf_lo(v.z); f[5] = bf_hi(v.z); f[6] = bf_lo(v.w); f[7] = bf_hi(v.w);
}
__device__ __forceinline__ u32x4 pack8(const float (&f)[8]) {
    u32x4 w; w.x = pk_bf16(f[0], f[1]); w.y = pk_bf16(f[2], f[3]); w.z = pk_bf16(f[4], f[5]); w.w = pk_bf16(f[6], f[7]); return w;
}
__device__ __forceinline__ float sigmoid_f(float x) { return 1.f / (1.f + __expf(-x)); }
__device__ __forceinline__ float silu_f(float x) { return x / (1.f + __expf(-x)); }
__device__ __forceinline__ float softplus_f(float x) { return x > 20.f ? x : log1pf(__expf(x)); }
__device__ __forceinline__ float wave_sum(float v) {
#pragma unroll
    for (int m = 32; m >= 1; m >>= 1) v += __shfl_xor(v, m);
    return v;
}

namespace pg8 {
constexpr int BM = 256, BK = 64, HALF = 128, HTB = HALF * BK * 2, STAGE_BYTES = 8 * HTB, NXCD = 8, WGM = 8;
__device__ __forceinline__ int lds_byte(int r, int c) { const int st = (r >> 4) * 2 + (c >> 5), rr = r & 15, cc = c & 31, ob = rr * 64 + cc * 2; return st * 1024 + (ob ^ (((ob >> 9) & 1) << 5)); }
__device__ __forceinline__ void stage_rc(int b, int& R, int& C) { const int st = b / 1024, sb = b % 1024, swz = sb ^ (((sb >> 9) & 1) << 5); R = (st >> 1) * 16 + swz / 64; C = (st & 1) * 32 + (swz % 64) / 2; }
__device__ __forceinline__ int perm32(int rho) { const int n = rho >> 4, i = rho & 15; return 8 * (i >> 2) + 4 * n + (i & 3); }
struct Unit { int pm, pn; };
struct Gemm { const bf16_t* A; const bf16_t* Bt; int M, N, K; };

struct Order {
    int nN, nlat, nctx, G, c;
    __device__ __forceinline__ void init(int nN_, int nNc, int G_, int c_) { nN = nN_; nlat = 64 * nN_; nctx = 8 * nNc; G = G_; c = c_; }
    __device__ __forceinline__ bool next(int i, Unit& u) const {
        long L = (long)i * G + c;
        if (L < nlat) {
            int wgid = (int)L; { const int q = nlat / NXCD, xcd = wgid % NXCD, off = wgid / NXCD; wgid = xcd * q + off; }
            const int nig = WGM * nN, gid = wgid / nig, fm = gid * WGM;
            u.pm = fm + ((wgid % nig) % WGM); u.pn = (wgid % nig) / WGM; return true;
        }
        L -= nlat; if (L >= nctx) return false;
        u.pm = 64 + (int)(L & 7); u.pn = (int)(L >> 3); return true;
    }
    __device__ __forceinline__ void a_ready(const Unit&) const {}
    __device__ __forceinline__ void done(const Unit&) const {}
};

template <int ACT  > struct EpiBf16 {
    static constexpr bool PERM = true;
    bf16_t* O; int ldc;
    __device__ __forceinline__ void operator()(const f32x4 (&acc)[2][2][4][2], const Unit& u, int wr, int wc, int fr, int fq) const {
        const int row0 = u.pm * BM + wr * 64 + fr, col0 = u.pn * BM + wc * 32 + 8 * fq;
#pragma unroll
        for (int ai = 0; ai < 2; ++ai)
#pragma unroll
            for (int m = 0; m < 4; ++m) { bf16_t* rowp = O + (size_t)(row0 + ai * HALF + m * 16) * ldc + col0;
#pragma unroll
                for (int bj = 0; bj < 2; ++bj) { f32x4 v0 = acc[ai][bj][m][0], v1 = acc[ai][bj][m][1];
                    if (ACT == 1) {
#pragma unroll
                        for (int j = 0; j < 4; ++j) { const float a = fmaxf(v0[j], 0.f), b = fmaxf(v1[j], 0.f); v0[j] = a * a; v1[j] = b * b; } }
                    u32x4 w; w.x = pk_bf16(v0[0], v0[1]); w.y = pk_bf16(v0[2], v0[3]); w.z = pk_bf16(v1[0], v1[1]); w.w = pk_bf16(v1[2], v1[3]);
                    *(u32x4*)(rowp + bj * HALF) = w; } }
    }
};
struct EpiGate {
    static constexpr bool PERM = false;
    const float* base_lat; float* out_lat; const float* base_ctx; float* out_ctx; const float* gate;
    __device__ __forceinline__ void operator()(const f32x4 (&acc)[2][2][4][2], const Unit& u, int wr, int wc, int fr, int fq) const {
        const int row0 = u.pm * BM + wr * 64 + fr, col0 = u.pn * BM + wc * 32 + 4 * fq;
        const bool isctx = u.pm >= 64; const int mrow = isctx ? 8 : (u.pm >> 3);
        const float* gp = gate + (size_t)mrow * 6144 + col0;
        const float* bp = isctx ? base_ctx - (size_t)NLAT * D : base_lat; float* op = isctx ? out_ctx - (size_t)NLAT * D : out_lat;
        f32x4 gv[2][2];
#pragma unroll
        for (int bj = 0; bj < 2; ++bj)
#pragma unroll
            for (int n = 0; n < 2; ++n) gv[bj][n] = *(const f32x4*)(gp + bj * HALF + n * 16);
#pragma unroll
        for (int ai = 0; ai < 2; ++ai)
#pragma unroll
            for (int m = 0; m < 4; ++m) { const size_t off = (size_t)(row0 + ai * HALF + m * 16) * D + col0;
#pragma unroll
                for (int bj = 0; bj < 2; ++bj)
#pragma unroll
                    for (int n = 0; n < 2; ++n) { const f32x4 bs = *(const f32x4*)(bp + off + bj * HALF + n * 16);
                        *(f32x4*)(op + off + bj * HALF + n * 16) = bs + gv[bj][n] * acc[ai][bj][m][n]; }
                asm volatile("" ::: "memory"); }
    }
};

template <class Epi, class Sched>
__device__ __forceinline__ void gemm_phase(lptr lds, const Gemm g, const Sched& S, const Epi& E, const int tid) {
    const int wid = __builtin_amdgcn_readfirstlane(tid >> 6), lane = tid & 63, wr = wid >> 2, wc = wid & 3, fr = lane & 15, fq = lane >> 4;
    const int K = g.K, nt = K / BK;
    unsigned voffA[2], voffB[2];
#pragma unroll
    for (int i = 0; i < 2; ++i) { int R, C; stage_rc(tid * 16 + i * 8192, R, C); const int Rb = Epi::PERM ? ((R & ~31) + perm32(R & 31)) : R;
        voffA[i] = (unsigned)(R * K + C) * 2u; voffB[i] = (unsigned)(Rb * K + C) * 2u; }
    const size_t kstep = (size_t)(BK * 2);
    const size_t hstep = (size_t)HALF * K * 2;
    const size_t tstep = 2 * hstep;
    const unsigned ldsw = (unsigned)wid * 1024u;
    const int aoff = lds_byte(wr * 64 + fr, fq * 8), boff = lds_byte(wc * 32 + fr, fq * 8);
#define PG8_SA(b, h) (((b) * 2 + (h)) * HTB)
#define PG8_SB(b, h) ((4 + (b) * 2 + (h)) * HTB)
#define PG8_STAGE(bufoff, gbase, voff) do { _Pragma("unroll") for (int _i = 0; _i < 2; ++_i) \
        __builtin_amdgcn_global_load_lds((const unsigned*)((const char*)(gbase) + (voff)[_i]), (LAS unsigned*)(lds + (bufoff) + ldsw + _i * 8192), 16, 0, 0); } while (0)
#define PG8_LDA(dst, b, h) do { _Pragma("unroll") for (int m = 0; m < 4; ++m) _Pragma("unroll") for (int k = 0; k < 2; ++k) dst[m][k] = *(const LAS bf16x8*)(lds + PG8_SA(b, h) + aoff + m * 2048 + k * 1024); } while (0)
#define PG8_LDB(dst, b, h) do { _Pragma("unroll") for (int n = 0; n < 2; ++n) _Pragma("unroll") for (int k = 0; k < 2; ++k) dst[n][k] = *(const LAS bf16x8*)(lds + PG8_SB(b, h) + boff + n * 2048 + k * 1024); } while (0)
#define PG8_MMA(ai, bj, At, Bt) do { __builtin_amdgcn_s_setprio(1); _Pragma("unroll") for (int m = 0; m < 4; ++m) _Pragma("unroll") for (int n = 0; n < 2; ++n) _Pragma("unroll") for (int k = 0; k < 2; ++k) \
        acc[ai][bj][m][n] = __builtin_amdgcn_mfma_f32_16x16x32_bf16(Bt[n][k], At[m][k], acc[ai][bj][m][n], 0, 0, 0); __builtin_amdgcn_s_setprio(0); } while (0)
#define PG8_WAIT_V(n) asm volatile("s_waitcnt vmcnt(" #n ")" ::: "memory")
#define PG8_WAIT_L(n) asm volatile("s_waitcnt lgkmcnt(" #n ")" ::: "memory")
#define PG8_BAR __builtin_amdgcn_s_barrier()
#define PG8_SCHED __builtin_amdgcn_sched_barrier(0)
    Unit cur, nxt; int ui = 0;
    if (!S.next(0, cur)) return;
    f32x4 acc[2][2][4][2];
#pragma unroll
    for (int a = 0; a < 2; ++a)
#pragma unroll
        for (int b = 0; b < 2; ++b)
#pragma unroll
            for (int m = 0; m < 4; ++m)
#pragma unroll
                for (int n = 0; n < 2; ++n) acc[a][b][m][n] = (f32x4){0.f, 0.f, 0.f, 0.f};
    bf16x8 At[4][2], B0[2][2], B1[2][2];
    const char* cA = (const char*)g.A + (size_t)cur.pm * tstep; const char* cB = (const char*)g.Bt + (size_t)cur.pn * tstep;
    S.a_ready(cur);
    PG8_STAGE(PG8_SB(0, 0), cB, voffB); PG8_STAGE(PG8_SA(0, 0), cA, voffA); PG8_STAGE(PG8_SB(0, 1), cB + hstep, voffB); PG8_STAGE(PG8_SA(0, 1), cA + hstep, voffA);
    if (wr == 1) PG8_BAR;
    PG8_WAIT_V(4); PG8_BAR;
    PG8_STAGE(PG8_SB(1, 0), cB + kstep, voffB); PG8_STAGE(PG8_SA(1, 0), cA + kstep, voffA); PG8_STAGE(PG8_SB(1, 1), cB + hstep + kstep, voffB);
    PG8_WAIT_V(6); PG8_BAR;
    for (;;) {
        const bool has_next = S.next(ui + 1, nxt);
        const char* nA = has_next ? (const char*)g.A + (size_t)nxt.pm * tstep : cA; const char* nB = has_next ? (const char*)g.Bt + (size_t)nxt.pn * tstep : cB;
        for (int t = 0; t < nt; t += 2) {
            const bool last = (t == nt - 2);
            const char* a1 = cA + (size_t)(t + 1) * kstep;
            const char* a2 = last ? nA : cA + (size_t)(t + 2) * kstep; const char* b2 = last ? nB : cB + (size_t)(t + 2) * kstep;
            const char* a3 = a2 + kstep; const char* b3 = b2 + kstep;
            if (last && has_next) S.a_ready(nxt);
            PG8_LDB(B0, 0, 0); PG8_SCHED; PG8_LDA(At, 0, 0); PG8_STAGE(PG8_SA(1, 1), a1 + hstep, voffA);
            PG8_WAIT_L(8); PG8_BAR; PG8_WAIT_L(0); PG8_MMA(0, 0, At, B0); PG8_BAR; PG8_SCHED;
            PG8_LDB(B1, 0, 1); PG8_STAGE(PG8_SB(0, 0), b2, voffB);
            PG8_BAR; PG8_WAIT_L(0); PG8_MMA(0, 1, At, B1); PG8_BAR;
            PG8_LDA(At, 0, 1); PG8_STAGE(PG8_SA(0, 0), a2, voffA);
            PG8_BAR; PG8_WAIT_L(0); PG8_MMA(1, 0, At, B0); PG8_BAR; PG8_SCHED;
            PG8_STAGE(PG8_SB(0, 1), b2 + hstep, voffB);
            PG8_WAIT_V(6); PG8_BAR; PG8_MMA(1, 1, At, B1); PG8_BAR;
            PG8_LDB(B0, 1, 0); PG8_SCHED; PG8_LDA(At, 1, 0); PG8_STAGE(PG8_SA(0, 1), a2 + hstep, voffA);
            PG8_WAIT_L(8); PG8_BAR; PG8_WAIT_L(0); PG8_MMA(0, 0, At, B0); PG8_BAR; PG8_SCHED;
            PG8_LDB(B1, 1, 1); PG8_STAGE(PG8_SB(1, 0), b3, voffB);
            PG8_BAR; PG8_WAIT_L(0); PG8_MMA(0, 1, At, B1); PG8_BAR;
            PG8_LDA(At, 1, 1); PG8_STAGE(PG8_SA(1, 0), a3, voffA);
            PG8_BAR; PG8_WAIT_L(0); PG8_MMA(1, 0, At, B0); PG8_BAR; PG8_SCHED;
            PG8_STAGE(PG8_SB(1, 1), b3 + hstep, voffB);
            PG8_WAIT_V(6); PG8_BAR; PG8_MMA(1, 1, At, B1); PG8_BAR;
        }
        E(acc, cur, wr, wc, fr, fq); S.done(cur);
        if (!has_next) break;
#pragma unroll
        for (int a = 0; a < 2; ++a)
#pragma unroll
            for (int b = 0; b < 2; ++b)
#pragma unroll
                for (int m = 0; m < 4; ++m)
#pragma unroll
                    for (int n = 0; n < 2; ++n) acc[a][b][m][n] = (f32x4){0.f, 0.f, 0.f, 0.f};
        cur = nxt; cA = nA; cB = nB; ++ui;
    }
    PG8_WAIT_V(0);
    if (wr == 0) PG8_BAR;
    PG8_BAR;
#undef PG8_SA
#undef PG8_SB
#undef PG8_STAGE
#undef PG8_LDA
#undef PG8_LDB
#undef PG8_MMA
#undef PG8_WAIT_V
#undef PG8_WAIT_L
#undef PG8_BAR
#undef PG8_SCHED
}
}

__device__ __forceinline__ void mod_unit(const Args& a, int u, lptr lds, const int tid) {
    LAS float* sl = (LAS float*)lds;
    LAS float* red = sl + 9 * 1024;
    for (int i = tid; i < 9 * 1024; i += NTHREADS) { const int r = i >> 10, k = i & 1023; const float v = r < 8 ? a.in[I_C][r * 1024 + k] : a.in[I_CCTX][k]; sl[i] = silu_f(v); }
    __syncthreads();
    const int l = u / 48, jb = u % 48, col = tid & 127, kq = tid >> 7;
    const float* w = a.in[I_ADAW] + (size_t)l * 1024 * 6144 + jb * 128 + col;
    float acc[9];
#pragma unroll
    for (int r = 0; r < 9; ++r) acc[r] = 0.f;
    for (int k = kq * 256; k < kq * 256 + 256; k += 4) {
        const float w0 = w[(size_t)k * 6144], w1 = w[(size_t)(k + 1) * 6144], w2 = w[(size_t)(k + 2) * 6144], w3 = w[(size_t)(k + 3) * 6144];
#pragma unroll
        for (int r = 0; r < 9; ++r) { const f32x4 s = *(const LAS f32x4*)(sl + r * 1024 + k); acc[r] += s[0] * w0 + s[1] * w1 + s[2] * w2 + s[3] * w3; }
    }
#pragma unroll
    for (int r = 0; r < 9; ++r) red[(kq * 9 + r) * 128 + col] = acc[r];
    __syncthreads();
    float* mod = (float*)(a.ws + WS_MOD);
    if (tid < 128) {
        const float bias = a.in[I_ADAB][l * 6144 + jb * 128 + tid];
#pragma unroll
        for (int r = 0; r < 9; ++r) {
            const float v = (red[(0 * 9 + r) * 128 + tid] + red[(1 * 9 + r) * 128 + tid]) + (red[(2 * 9 + r) * 128 + tid] + red[(3 * 9 + r) * 128 + tid]) + bias;
            mod[(size_t)(l * 9 + r) * 6144 + jb * 128 + tid] = v; }
    }
    __syncthreads();
}
__device__ __forceinline__ void convert_tile(const float* src, int ld, int k0, int c0, bf16_t* dst, int K, int n0, lptr lds, const int tid) {
    LAS float* T = (LAS float*)lds;
    const int r = tid >> 4, c4 = (tid & 15) * 4;
#pragma unroll
    for (int i = 0; i < 2; ++i) { const int row = r + 32 * i; const f32x4 v = *(const f32x4*)(src + (size_t)(k0 + row) * ld + c0 + c4);
        T[row * 65 + c4 + 0] = v[0]; T[row * 65 + c4 + 1] = v[1]; T[row * 65 + c4 + 2] = v[2]; T[row * 65 + c4 + 3] = v[3]; }
    __syncthreads();
    const int n = tid >> 3, k8 = (tid & 7) * 8; float f[8];
#pragma unroll
    for (int e = 0; e < 8; ++e) f[e] = T[(k8 + e) * 65 + n];
    *(u32x4*)(dst + (size_t)(n0 + n) * K + k0 + k8) = pack8(f);
    __syncthreads();
}
__device__ __forceinline__ void phase_prep(const Args& a, lptr lds, const int tid, const int bid) {
    for (int u = bid; u < 96; u += gridDim.x) mod_unit(a, u, lds, tid);
    for (int t = bid; t < 2 * 2944; t += gridDim.x) {
        const int l = t / 2944; int tt = t % 2944;
        const float* src; int ld, c0, K, n0; bf16_t* dst; bf16_t* wt = (bf16_t*)(a.ws + WS_WT + (size_t)l * WT_LAYER);
        if (tt < 384)       { src = a.in[I_WIN] + (size_t)l * 1024 * 2576; ld = 2576; c0 = 0; K = 1024; n0 = 0; dst = wt + WT_WIN / 2; }
        else if (tt < 640)  { tt -= 384; src = a.in[I_WIN] + (size_t)l * 1024 * 2576; ld = 2576; c0 = 1552; K = 1024; n0 = 1536; dst = wt + WT_WIN / 2; }
        else if (tt < 896)  { tt -= 640; src = a.in[I_WOUT] + (size_t)l * 1024 * 1024; ld = 1024; c0 = 0; K = 1024; n0 = 0; dst = wt + WT_WOUT / 2; }
        else if (tt < 1920) { tt -= 896; src = a.in[I_W1] + (size_t)l * 1024 * 4096; ld = 4096; c0 = 0; K = 1024; n0 = 0; dst = wt + WT_W1 / 2; }
        else                { tt -= 1920; src = a.in[I_W2] + (size_t)l * 4096 * 1024; ld = 1024; c0 = 0; K = 4096; n0 = 0; dst = wt + WT_W2 / 2; }
        const int nk = K / 64, kt = tt % nk, ntile = tt / nk;
        convert_tile(src, ld, kt * 64, c0 + ntile * 64, dst, K, n0 + ntile * 64, lds, tid);
    }
}

__device__ __forceinline__ void phase_norm(const Args& a, int l, int which, int nrows, const float* xlat, const float* xctx, lptr lds, const int tid, const int bid) {
    const int lane = tid & 63, wave = tid >> 6;
    const float* g = a.in[which ? I_N2G : I_N1G] + l * 1024;
    const float* mod = (const float*)(a.ws + WS_MOD) + (size_t)l * 9 * 6144 + (which ? 3072 : 0);
    bf16_t* hb = (bf16_t*)(a.ws + WS_H);
    float* dtb = (float*)(a.ws + WS_DT);
    LAS float* Wdt = (LAS float*)lds;
    if (which == 0) {
        const float* win = a.in[I_WIN] + (size_t)l * 1024 * 2576 + 1536;
        for (int i = tid; i < 16384; i += NTHREADS) { const int c = i >> 4, j = i & 15; Wdt[j * 1024 + c] = win[(size_t)c * 2576 + j]; }
        __syncthreads();
    }
    for (int row = bid * 8 + wave; row < nrows; row += gridDim.x * 8) {
        const float* xr = row < NLAT ? xlat + (size_t)row * D : xctx + (size_t)(row - NLAT) * D;
        const float* mr = mod + (size_t)(row < NLAT ? (row >> 11) : 8) * 6144;
        f32x4 v[4]; float ss = 0.f;
#pragma unroll
        for (int i = 0; i < 4; ++i) { v[i] = *(const f32x4*)(xr + lane * 4 + 256 * i); ss += v[i][0] * v[i][0] + v[i][1] * v[i][1] + v[i][2] * v[i][2] + v[i][3] * v[i][3]; }
        ss = wave_sum(ss);
        const float rstd = rsqrtf(ss * (1.f / 1024.f) + EPS);
#pragma unroll
        for (int i = 0; i < 4; ++i) { const int c = lane * 4 + 256 * i;
            const f32x4 gg = *(const f32x4*)(g + c), sh = *(const f32x4*)(mr + c), sc = *(const f32x4*)(mr + 1024 + c);
            v[i] = (v[i] * rstd * gg) * (sc + 1.f) + sh;
            u32x2 w; w.x = pk_bf16(v[i][0], v[i][1]); w.y = pk_bf16(v[i][2], v[i][3]);
            *(u32x2*)(hb + (size_t)row * D + c) = w; }
        if (which == 0) {
            float mine = 0.f;
#pragma unroll
            for (int j = 0; j < 16; ++j) { float acc = 0.f;
#pragma unroll
                for (int i = 0; i < 4; ++i) { const f32x4 w = *(const LAS f32x4*)(Wdt + j * 1024 + lane * 4 + 256 * i); acc += v[i][0] * w[0] + v[i][1] * w[1] + v[i][2] * w[2] + v[i][3] * w[3]; }
                acc = wave_sum(acc); if (lane == j) mine = acc; }
            if (lane < 16) dtb[(size_t)row * 16 + lane] = mine;
        }
    }
}

__device__ __forceinline__ void phase_conv(const Args& a, int l, const int tid, const int bid) {
    const int v = tid & 127, rsub = tid >> 7;
    const bf16_t* proj = (const bf16_t*)(a.ws + WS_PROJ);
    bf16_t* xc = (bf16_t*)(a.ws + WS_H);
    float cw[4][8], cb[8];
    const float* cwp = a.in[I_SCW] + (size_t)l * 4 * 1024 + v * 8; const float* cbp = a.in[I_SCB] + (size_t)l * 1024 + v * 8;
#pragma unroll
    for (int k = 0; k < 4; ++k)
#pragma unroll
        for (int e = 0; e < 8; ++e) cw[k][e] = cwp[k * 1024 + e];
#pragma unroll
    for (int e = 0; e < 8; ++e) cb[e] = cbp[e];
    for (int o = bid * 4 + rsub; o < NROW; o += gridDim.x * 4) {
        float acc[8];
#pragma unroll
        for (int e = 0; e < 8; ++e) acc[e] = cb[e];
        const bool isctx = o >= NLAT; const int b = isctx ? (o - NLAT) >> 8 : o >> 11; const int pos = isctx ? (o - NLAT) & 255 : o & 2047; const int len = isctx ? 256 : 2048;
#pragma unroll
        for (int k = 0; k < 4; ++k) { const int p = pos + k - 1;
            if (p >= 0 && p < len) {
                const size_t srow = isctx ? (size_t)(NLAT + b * 256 + p) : (size_t)(b * 2048 + (p & 31) * 64 + (p >> 5));
                const u32x4 rv = *(const u32x4*)(proj + srow * NPROJ + 512 + v * 8); float f[8]; unpack8(rv, f);
#pragma unroll
                for (int e = 0; e < 8; ++e) acc[e] += cw[k][e] * f[e]; } }
#pragma unroll
        for (int e = 0; e < 8; ++e) acc[e] = silu_f(acc[e]);
        *(u32x4*)(xc + (size_t)o * 1024 + v * 8) = pack8(acc);
    }
}

__device__ __forceinline__ void lru_load(const bf16_t* proj, int st, int b, int d, int head, int tid, u32x4 (&raw)[4]) {
    const bool isctx = st < 4; const int k = isctx ? st : st - 4, nblk = isctx ? 4 : 32, len = isctx ? 256 : 2048, rowbase = isctx ? NLAT + b * 256 : b * 2048;
    const int blk = d ? nblk - 1 - k : k, s = tid >> 3, cg8 = tid & 7; const int pos = d ? blk * 64 + 63 - s : blk * 64 + s;
#pragma unroll
    for (int kk = 0; kk < 4; ++kk) { const int p = pos + kk - 1;
        raw[kk] = (p >= 0 && p < len) ? *(const u32x4*)(proj + (size_t)(rowbase + p) * NPROJ + head * 64 + cg8 * 8) : (u32x4){0u, 0u, 0u, 0u}; }
}
__device__ __forceinline__ void lru_unit(const Args& a, int l, int b, int d, int head, bool ctx_out, lptr lds, const int tid) {
    const int lane = tid & 63, wave = tid >> 6, quad = lane >> 4, r16 = lane & 15;
    LAS bf16_t* WaT = (LAS bf16_t*)lds;
    LAS bf16_t* WxT = WaT + 64 * 72;
    LAS bf16_t* ub = WxT + 64 * 72;
    LAS float* uf = (LAS float*)(lds + 3 * 64 * 72 * 2);
    LAS float* av = uf + 4096; LAS float* bv = av + 4096;
    LAS float* sumA = bv + 4096; LAS float* sumH = sumA + 512; LAS float* carry = sumH + 512;
    const bf16_t* proj = (const bf16_t*)(a.ws + WS_PROJ);
    bf16_t* yout = (bf16_t*)(a.ws + WS_YD + (size_t)d * YD_ONE);
    {
        const float* wa = a.in[I_LWA] + ((((size_t)l * 2 + d) * 8 + head) * 4096); const float* wx = a.in[I_LWX] + ((((size_t)l * 2 + d) * 8 + head) * 4096);
        for (int idx = tid; idx < 4096; idx += NTHREADS) { const int i = idx >> 6, j = idx & 63; WaT[j * 72 + i] = to_bf16(wa[idx]); WxT[j * 72 + i] = to_bf16(wx[idx]); }
        if (tid < 128) carry[tid] = 0.f;
    }
    const int cg8 = tid & 7;
    float cw[4][8], cb[8];
    {
        const float* cwp = a.in[I_LCW] + (size_t)l * 4 * 512 + head * 64 + cg8 * 8; const float* cbp = a.in[I_LCB] + (size_t)l * 512 + head * 64 + cg8 * 8;
#pragma unroll
        for (int k = 0; k < 4; ++k)
#pragma unroll
            for (int e = 0; e < 8; ++e) cw[k][e] = cwp[k * 512 + e];
#pragma unroll
        for (int e = 0; e < 8; ++e) cb[e] = cbp[e];
    }
    const int tr = wave & 3, chb0 = (wave >> 2) * 2;
    float ba_v[2], bx_v[2], sp_v[2];
#pragma unroll
    for (int q = 0; q < 2; ++q) { const int gch = (l * 2 + d) * 512 + head * 64 + (chb0 + q) * 16 + r16;
        ba_v[q] = a.in[I_LBA][gch]; bx_v[q] = a.in[I_LBX][gch]; sp_v[q] = -8.f * softplus_f(-a.in[I_LLAM][gch]); }
    u32x4 raw[4];
    lru_load(proj, 0, b, d, head, tid, raw);
    for (int st = 0; st < 36; ++st) {
        const bool isctx = st < 4; const int k = isctx ? st : st - 4, nblk = isctx ? 4 : 32, rowbase = isctx ? NLAT + b * 256 : b * 2048;
        const int blk = d ? nblk - 1 - k : k;
        {
            float u[8];
#pragma unroll
            for (int e = 0; e < 8; ++e) u[e] = cb[e];
#pragma unroll
            for (int kk = 0; kk < 4; ++kk) { float f[8]; unpack8(raw[kk], f);
#pragma unroll
                for (int e = 0; e < 8; ++e) u[e] += cw[kk][e] * f[e]; }
            const int s = tid >> 3;
            *(LAS f32x4*)(uf + s * 64 + cg8 * 8) = (f32x4){u[0], u[1], u[2], u[3]}; *(LAS f32x4*)(uf + s * 64 + cg8 * 8 + 4) = (f32x4){u[4], u[5], u[6], u[7]};
            *(LAS u32x4*)(ub + s * 72 + cg8 * 8) = pack8(u);
        }
        if (st + 1 < 36) lru_load(proj, st + 1, b, d, head, tid, raw);
        __syncthreads();
#pragma unroll
        for (int q = 0; q < 2; ++q) {
            const int chb = chb0 + q; f32x4 ar = (f32x4){0.f, 0.f, 0.f, 0.f}, ai = ar;
#pragma unroll
            for (int kk = 0; kk < 2; ++kk) {
                const bf16x8 af = *(const LAS bf16x8*)(ub + (tr * 16 + r16) * 72 + kk * 32 + quad * 8);
                const bf16x8 br = *(const LAS bf16x8*)(WaT + (chb * 16 + r16) * 72 + kk * 32 + quad * 8);
                const bf16x8 bi = *(const LAS bf16x8*)(WxT + (chb * 16 + r16) * 72 + kk * 32 + quad * 8);
                ar = __builtin_amdgcn_mfma_f32_16x16x32_bf16(af, br, ar, 0, 0, 0);
                ai = __builtin_amdgcn_mfma_f32_16x16x32_bf16(af, bi, ai, 0, 0, 0);
            }
            const int ch = chb * 16 + r16;
#pragma unroll
            for (int j = 0; j < 4; ++j) { const int s = tr * 16 + quad * 4 + j;
                const float r = sigmoid_f(ar[j] + ba_v[q]), ii = sigmoid_f(ai[j] + bx_v[q]);
                const float la = sp_v[q] * r; const float aa = __expf(la); const float mm = sqrtf(fmaxf(-expm1f(2.f * la), 0.f));
                av[s * 64 + ch] = aa; bv[s * 64 + ch] = mm * ii * uf[s * 64 + ch]; }
        }
        __syncthreads();
        float hl[8], Al[8];
        { float h = 0.f, A = 1.f;
#pragma unroll
            for (int t = 0; t < 8; ++t) { const float aa = av[(wave * 8 + t) * 64 + lane], bb = bv[(wave * 8 + t) * 64 + lane]; h = aa * h + bb; A *= aa; hl[t] = h; Al[t] = A; }
            sumA[wave * 64 + lane] = A; sumH[wave * 64 + lane] = h; }
        __syncthreads();
        float c = carry[(st & 1) * 64 + lane];
#pragma unroll
        for (int q = 0; q < 8; ++q) if (q < wave) c = sumA[q * 64 + lane] * c + sumH[q * 64 + lane];
        const bool store = !isctx || ctx_out;
#pragma unroll
        for (int t = 0; t < 8; ++t) { const float hf = hl[t] + Al[t] * c; const int s = wave * 8 + t; const int pos = d ? blk * 64 + 63 - s : blk * 64 + s;
            if (store) yout[(size_t)(rowbase + pos) * 512 + head * 64 + lane] = to_bf16(hf);
            if (t == 7 && wave == 7) carry[((st + 1) & 1) * 64 + lane] = hf; }
    }
    __syncthreads();
}

__device__ __forceinline__ void ssd_load(const bf16_t* xc, const float* dtb, int st, int b, int d, int h, int tid, u32x4 (&rr)[5], float& dtr) {
    const bool isctx = st < 4; const int k = isctx ? st : st - 4, nblk = isctx ? 4 : 32; const int blk = d ? nblk - 1 - k : k, base = blk * 64;
    const size_t orow0 = (size_t)(isctx ? NLAT + b * 256 : b * 2048) + base; const int g = h >> 2;
#pragma unroll
    for (int i = 0; i < 4; ++i) { const int q = tid + 512 * (i & 1), lq = q >> 4, v = q & 15; const int prow = d ? 63 - lq : lq;
        rr[i] = *(const u32x4*)(xc + (orow0 + prow) * 1024 + (i < 2 ? 512 : 768) + g * 128 + v * 8); }
    { const int lq = tid >> 3, v = tid & 7; const int prow = d ? 63 - lq : lq; rr[4] = *(const u32x4*)(xc + (orow0 + prow) * 1024 + h * 64 + v * 8); }
    if (tid < 64) { const int pos = base + (d ? 63 - tid : tid); const size_t grow = isctx ? (size_t)(NLAT + b * 256 + pos) : (size_t)(b * 2048 + (pos & 31) * 64 + (pos >> 5));
        dtr = dtb[grow * 16 + d * 8 + h]; }
}
__device__ __forceinline__ void ssd_unit(const Args& a, int l, int b, int d, int h, bool ctx_out, lptr lds, const int tid) {
    const int lane = tid & 63, wave = tid >> 6, quad = lane >> 4, r16 = lane & 15;
    LAS bf16_t* Cs = (LAS bf16_t*)lds;
    LAS bf16_t* Bs = Cs + 64 * 136;
    LAS bf16_t* BT = Bs + 64 * 136;
    LAS bf16_t* XT = BT + 128 * 72;
    LAS bf16_t* Xr = XT + 64 * 72;
    LAS bf16_t* Ms = Xr + 64 * 72;
    LAS bf16_t* Sb = Ms + 64 * 72;
    LAS float* acs = (LAS float*)(Sb + 64 * 136);
    LAS float* dtv = acs + 64;
    const bf16_t* xc = (const bf16_t*)(a.ws + WS_H);
    const float* dtb = (const float*)(a.ws + WS_DT);
    bf16_t* yout = (bf16_t*)(a.ws + WS_YD + (size_t)(2 + d) * YD_ONE);
    const float dt_bias = a.in[I_SDTB][(l * 2 + d) * 8 + h], negA = -__expf(a.in[I_SALOG][(l * 2 + d) * 8 + h]), Dh = (d == 0) ? a.in[I_SD][l * 8 + h] : 0.f;
    for (int i = tid; i < 64 * 136 / 2; i += NTHREADS) ((LAS unsigned*)Sb)[i] = 0u;
    f32x4 Sacc[4];
#pragma unroll
    for (int q = 0; q < 4; ++q) Sacc[q] = (f32x4){0.f, 0.f, 0.f, 0.f};
    u32x4 rr[5]; float dtr = 0.f;
    ssd_load(xc, dtb, 0, b, d, h, tid, rr, dtr);
    for (int st = 0; st < 36; ++st) {
        const bool isctx = st < 4; const int k = isctx ? st : st - 4, nblk = isctx ? 4 : 32; const int blk = d ? nblk - 1 - k : k, base = blk * 64;
#pragma unroll
        for (int i = 0; i < 4; ++i) { const int q = tid + 512 * (i & 1), lq = q >> 4, v = q & 15; *(LAS u32x4*)((i < 2 ? Bs : Cs) + lq * 136 + v * 8) = rr[i]; }
        { const int lq = tid >> 3, v = tid & 7; *(LAS u32x4*)(Xr + lq * 72 + v * 8) = rr[4]; }
        if (wave == 0) {
            const float dt = softplus_f(dtr + dt_bias); float cs = dt * negA;
#pragma unroll
            for (int off = 1; off < 64; off <<= 1) { const float t = __shfl_up(cs, off); if (lane >= off) cs += t; }
            acs[lane] = cs; dtv[lane] = dt;
        }
        __syncthreads();
        if (st + 1 < 36) ssd_load(xc, dtb, st + 1, b, d, h, tid, rr, dtr);
        const float alast = acs[63];
#pragma unroll
        for (int i = 0; i < 3; ++i) { const int lq = lane, v = wave + 8 * i;
            if (i == 0) { const u32x4 xv = *(const LAS u32x4*)(Xr + lq * 72 + v * 8); float f[8]; unpack8(xv, f); const float s = dtv[lq];
#pragma unroll
                for (int e = 0; e < 8; ++e) XT[(v * 8 + e) * 72 + lq] = to_bf16(f[e] * s); }
            else { const int vb = v - 8; const u32x4 bvv = *(const LAS u32x4*)(Bs + lq * 136 + vb * 8); float f[8]; unpack8(bvv, f); const float s = __expf(alast - acs[lq]);
#pragma unroll
                for (int e = 0; e < 8; ++e) BT[(vb * 8 + e) * 72 + lq] = to_bf16(f[e] * s); } }
        { const int tl = wave & 3, ts0 = (wave >> 2) * 2;
#pragma unroll
          for (int q = 0; q < 2; ++q) { const int ts = ts0 + q; f32x4 acc = (f32x4){0.f, 0.f, 0.f, 0.f};
            if (ts <= tl) {
#pragma unroll
                for (int kk = 0; kk < 4; ++kk) { const bf16x8 af = *(const LAS bf16x8*)(Cs + (tl * 16 + r16) * 136 + kk * 32 + quad * 8); const bf16x8 bf = *(const LAS bf16x8*)(Bs + (ts * 16 + r16) * 136 + kk * 32 + quad * 8);
                    acc = __builtin_amdgcn_mfma_f32_16x16x32_bf16(bf, af, acc, 0, 0, 0); } }
            const int ll = tl * 16 + r16; const float al = acs[ll]; float m[4];
#pragma unroll
            for (int j = 0; j < 4; ++j) { const int s = ts * 16 + quad * 4 + j; m[j] = (s <= ll) ? acc[j] * __expf(al - acs[s]) : 0.f; }
            u32x2 w; w.x = pk_bf16(m[0], m[1]); w.y = pk_bf16(m[2], m[3]); *(LAS u32x2*)(Ms + ll * 72 + ts * 16 + quad * 4) = w; } }
        __syncthreads();
        if (!isctx || ctx_out) { const int tl = wave & 3, tp0 = (wave >> 2) * 2; const int ll = tl * 16 + r16; const float ea = __expf(acs[ll]);
            const int pos = base + (d ? 63 - ll : ll); const size_t grow = isctx ? (size_t)(NLAT + b * 256 + pos) : (size_t)(b * 2048 + (pos & 31) * 64 + (pos >> 5));
#pragma unroll
            for (int q = 0; q < 2; ++q) { const int tp = tp0 + q; f32x4 a1 = (f32x4){0.f, 0.f, 0.f, 0.f}, a2 = a1;
#pragma unroll
                for (int kk = 0; kk < 2; ++kk) { const bf16x8 af = *(const LAS bf16x8*)(Ms + (tl * 16 + r16) * 72 + kk * 32 + quad * 8); const bf16x8 bf = *(const LAS bf16x8*)(XT + (tp * 16 + r16) * 72 + kk * 32 + quad * 8);
                    a1 = __builtin_amdgcn_mfma_f32_16x16x32_bf16(bf, af, a1, 0, 0, 0); }
#pragma unroll
                for (int kk = 0; kk < 4; ++kk) { const bf16x8 af = *(const LAS bf16x8*)(Cs + (tl * 16 + r16) * 136 + kk * 32 + quad * 8); const bf16x8 bf = *(const LAS bf16x8*)(Sb + (tp * 16 + r16) * 136 + kk * 32 + quad * 8);
                    a2 = __builtin_amdgcn_mfma_f32_16x16x32_bf16(bf, af, a2, 0, 0, 0); }
                const u32x2 xv = *(const LAS u32x2*)(Xr + ll * 72 + tp * 16 + quad * 4);
                const float y0 = a1[0] + ea * a2[0] + Dh * bf_lo(xv.x), y1 = a1[1] + ea * a2[1] + Dh * bf_hi(xv.x), y2 = a1[2] + ea * a2[2] + Dh * bf_lo(xv.y), y3 = a1[3] + ea * a2[3] + Dh * bf_hi(xv.y);
                u32x2 w; w.x = pk_bf16(y0, y1); w.y = pk_bf16(y2, y3); *(u32x2*)(yout + grow * 512 + h * 64 + tp * 16 + quad * 4) = w; } }
        { const int tp = wave & 3, tn0 = (wave >> 2) * 4; const float eal = __expf(alast);
#pragma unroll
          for (int q = 0; q < 4; ++q) { const int tn = tn0 + q; Sacc[q] = Sacc[q] * eal;
#pragma unroll
            for (int kk = 0; kk < 2; ++kk) { const bf16x8 af = *(const LAS bf16x8*)(XT + (tp * 16 + r16) * 72 + kk * 32 + quad * 8); const bf16x8 bf = *(const LAS bf16x8*)(BT + (tn * 16 + r16) * 72 + kk * 32 + quad * 8);
                Sacc[q] = __builtin_amdgcn_mfma_f32_16x16x32_bf16(bf, af, Sacc[q], 0, 0, 0); } } }
        __syncthreads();
        { const int tp = wave & 3, tn0 = (wave >> 2) * 4;
#pragma unroll
          for (int q = 0; q < 4; ++q) { u32x2 w; w.x = pk_bf16(Sacc[q][0], Sacc[q][1]); w.y = pk_bf16(Sacc[q][2], Sacc[q][3]); *(LAS u32x2*)(Sb + (tp * 16 + r16) * 136 + (tn0 + q) * 16 + quad * 4) = w; } }
    }
    __syncthreads();
}
__device__ __forceinline__ void phase_scan(const Args& a, int l, lptr lds, const int tid, const int bid) {
    const bool ctx_out = (l == 0);
    for (int u = bid; u < 256; u += gridDim.x) {
        const int kind = u & 1, r = u >> 1, b = r & 7, d = (r >> 3) & 1, hh = r >> 4;
        if (kind == 0) lru_unit(a, l, b, d, hh, ctx_out, lds, tid); else ssd_unit(a, l, b, d, hh, ctx_out, lds, tid);
    }
}

__device__ __forceinline__ void phase_combine(const Args& a, int l, int nrows, const int tid, const int bid) {
    const int lane = tid & 63, wave = tid >> 6, c8 = lane * 8;
    const bf16_t* proj = (const bf16_t*)(a.ws + WS_PROJ);
    const bf16_t* y0 = (const bf16_t*)(a.ws + WS_YD); const bf16_t* y1 = y0 + YD_ONE / 2; const bf16_t* s0 = y1 + YD_ONE / 2; const bf16_t* s1 = s0 + YD_ONE / 2;
    bf16_t* cat = (bf16_t*)(a.ws + WS_H);
    float gn[8];
#pragma unroll
    for (int e = 0; e < 8; ++e) gn[e] = a.in[I_SNG][l * 512 + c8 + e];
    for (int row = bid * 8 + wave; row < nrows; row += gridDim.x * 8) {
        const u32x4 va = *(const u32x4*)(y0 + (size_t)row * 512 + c8), vb = *(const u32x4*)(y1 + (size_t)row * 512 + c8), vg = *(const u32x4*)(proj + (size_t)row * NPROJ + 1536 + c8);
        const u32x4 vs0 = *(const u32x4*)(s0 + (size_t)row * 512 + c8), vs1 = *(const u32x4*)(s1 + (size_t)row * 512 + c8), vz = *(const u32x4*)(proj + (size_t)row * NPROJ + 2048 + c8);
        float fa[8], fb[8], fg[8], o[8];
        unpack8(va, fa); unpack8(vb, fb); unpack8(vg, fg);
#pragma unroll
        for (int e = 0; e < 8; ++e) { const float x = fg[e]; const float t = 1.5957691216057308f * (x + 0.044715f * x * x * x); o[e] = (fa[e] + fb[e]) * (x * sigmoid_f(t)); }
        *(u32x4*)(cat + (size_t)row * D + c8) = pack8(o);
        unpack8(vs0, fa); unpack8(vs1, fb); unpack8(vz, fg);
        float ss = 0.f;
#pragma unroll
        for (int e = 0; e < 8; ++e) { o[e] = (fa[e] + fb[e]) * silu_f(fg[e]); ss += o[e] * o[e]; }
#pragma unroll
        for (int m = 16; m >= 1; m >>= 1) ss += __shfl_xor(ss, m);
        const float rs = rsqrtf(ss * (1.f / 256.f) + EPS);
#pragma unroll
        for (int e = 0; e < 8; ++e) o[e] = o[e] * rs * gn[e];
        *(u32x4*)(cat + (size_t)row * D + 512 + c8) = pack8(o);
    }
}

__device__ __forceinline__ void phase_final(const Args& a, const int tid, const int bid) {
    const int lane = tid & 63, wave = tid >> 6;
    const float* g = a.in[I_FG];
    for (int row = bid * 8 + wave; row < NLAT; row += gridDim.x * 8) {
        float* xr = a.out + (size_t)row * D; f32x4 v[4]; float ss = 0.f;
#pragma unroll
        for (int i = 0; i < 4; ++i) { v[i] = *(const f32x4*)(xr + lane * 4 + 256 * i); ss += v[i][0] * v[i][0] + v[i][1] * v[i][1] + v[i][2] * v[i][2] + v[i][3] * v[i][3]; }
        ss = wave_sum(ss);
        const float rstd = rsqrtf(ss * (1.f / 1024.f) + EPS);
#pragma unroll
        for (int i = 0; i < 4; ++i) { const f32x4 gg = *(const f32x4*)(g + lane * 4 + 256 * i); *(f32x4*)(xr + lane * 4 + 256 * i) = v[i] * rstd * gg; }
    }
}

constexpr int NPHASE = 20;
__global__ void __launch_bounds__(NTHREADS, 2) mk_fwd(Args a) {
    extern __shared__ __attribute__((aligned(16))) unsigned char lds_raw[];
    lptr lds = (lptr)lds_raw;
    cg::grid_group grid = cg::this_grid();
    const int G = gridDim.x;
    for (int ph = a.ph_lo; ph < a.ph_hi; ++ph) {
        if (ph > a.ph_lo) grid.sync();
        int tid = threadIdx.x, bid = blockIdx.x;
        asm volatile("" : "+v"(tid)); asm volatile("" : "+s"(bid));
        if (ph == 0) { phase_prep(a, lds, tid, bid); continue; }
        if (ph == 19) { phase_final(a, tid, bid); continue; }
        const int l = (ph - 1) / 9, s = (ph - 1) % 9;
        float* ctxres = (float*)(a.ws + WS_CTX);
        const bool orig = (l == 0 && s <= 5);
        const float* xlat = orig ? a.in[I_X] : a.out;
        const float* xctx = orig ? a.in[I_CTX] : ctxres;
        bf16_t* wt = (bf16_t*)(a.ws + WS_WT + (size_t)l * WT_LAYER);
        bf16_t* hb = (bf16_t*)(a.ws + WS_H);
        const float* mod = (const float*)(a.ws + WS_MOD) + (size_t)l * 9 * 6144;
        switch (s) {
        case 0: phase_norm(a, l, 0, NROW, xlat, xctx, lds, tid, bid); break;
        case 1: { pg8::Gemm g{hb, wt + WT_WIN / 2, NROW, NPROJ, D}; pg8::Order S; S.init(10, l == 0 ? 10 : 6, G, bid);
                  pg8::EpiBf16<0> E{(bf16_t*)(a.ws + WS_PROJ), NPROJ}; pg8::gemm_phase(lds, g, S, E, tid); } break;
        case 2: phase_conv(a, l, tid, bid); break;
        case 3: phase_scan(a, l, lds, tid, bid); break;
        case 4: phase_combine(a, l, l == 0 ? NROW : NLAT, tid, bid); break;
        case 5: { pg8::Gemm g{hb, wt + WT_WOUT / 2, NROW, D, D}; pg8::Order S; S.init(4, l == 0 ? 4 : 0, G, bid);
                  pg8::EpiGate E{xlat, a.out, xctx, ctxres, mod + 2048}; pg8::gemm_phase(lds, g, S, E, tid); } break;
        case 6: phase_norm(a, l, 1, l == 0 ? NROW : NLAT, a.out, ctxres, lds, tid, bid); break;
        case 7: { pg8::Gemm g{hb, wt + WT_W1 / 2, NROW, DFF, D}; pg8::Order S; S.init(16, l == 0 ? 16 : 0, G, bid);
                  pg8::EpiBf16<1> E{(bf16_t*)(a.ws + WS_HID), DFF}; pg8::gemm_phase(lds, g, S, E, tid); } break;
        case 8: { pg8::Gemm g{(const bf16_t*)(a.ws + WS_HID), wt + WT_W2 / 2, NROW, D, DFF}; pg8::Order S; S.init(4, l == 0 ? 4 : 0, G, bid);
                  pg8::EpiGate E{a.out, a.out, ctxres, ctxres, mod + 5120}; pg8::gemm_phase(lds, g, S, E, tid); } break;
        }
        __syncthreads();
    }
}

extern "C" void kernel_launch(void* const* d_in, const int* in_sizes, int n_in, void* d_out, int out_size, void* d_ws, size_t ws_size, hipStream_t stream) {
    static int grid = 0;
    if (grid == 0) {
        if (n_in != 26 || ws_size < WS_END) { fprintf(stderr, "kernel_launch: unexpected n_in %d / ws_size %zu\n", n_in, ws_size); grid = -1; return; }
        int dev = 0, cus = 0, per_cu = 0;
        if (hipGetDevice(&dev) != hipSuccess || hipDeviceGetAttribute(&cus, hipDeviceAttributeMultiprocessorCount, dev) != hipSuccess) { grid = -1; return; }
        if (hipFuncSetAttribute((const void*)mk_fwd, hipFuncAttributeMaxDynamicSharedMemorySize, LDS_BYTES) != hipSuccess) { fprintf(stderr, "kernel_launch: hipFuncSetAttribute failed\n"); grid = -1; return; }
        if (hipOccupancyMaxActiveBlocksPerMultiprocessor(&per_cu, (const void*)mk_fwd, NTHREADS, LDS_BYTES) != hipSuccess || per_cu < 1) { fprintf(stderr, "kernel_launch: occupancy query says %d\n", per_cu); per_cu = 1; }
        (void)hipGetLastError();
        grid = cus;
    }
    if (grid < 0) return;
    Args a{};
    for (int i = 0; i < 26; ++i) a.in[i] = (const float*)d_in[i];
    a.out = (float*)d_out; a.ws = (unsigned char*)d_ws;
#if ONE_LAUNCH
    a.ph_lo = 0; a.ph_hi = NPHASE;
    void* args[] = {&a};
    hipError_t e = hipLaunchCooperativeKernel((const void*)mk_fwd, dim3(grid), dim3(NTHREADS), args, LDS_BYTES, stream);
    if (e != hipSuccess) fprintf(stderr, "cooperative launch failed: %s (grid %d)\n", hipGetErrorString(e), grid);
#else
    for (int p = 0; p < NPHASE; ++p) { a.ph_lo = p; a.ph_hi = p + 1; hipLaunchKernelGGL(mk_fwd, dim3(grid), dim3(NTHREADS), LDS_BYTES, stream, a); }
#endif
}
```

```cpp
#include <hip/hip_runtime.h>
#include <hip/hip_cooperative_groups.h>
#include <cstdio>
namespace cg = cooperative_groups;

#ifndef ONE_LAUNCH
#define ONE_LAUNCH 1
#endif

#ifndef PROBE_S
#define PROBE_S -1
#endif
#define LAS __attribute__((address_space(3)))
typedef unsigned short bf16_t;
typedef short bf16x8 __attribute__((ext_vector_type(8)));
typedef float f32x4 __attribute__((ext_vector_type(4)));
typedef float f32x2 __attribute__((ext_vector_type(2)));
typedef unsigned u32x4 __attribute__((ext_vector_type(4)));
typedef unsigned u32x2 __attribute__((ext_vector_type(2)));
typedef LAS unsigned char* lptr;

constexpr int D = 1024, NLAT = 16384, NCTXR = 2048, NROW = 18432, NPROJ = 2560, DFF = 4096;
constexpr int NTHREADS = 512;
constexpr int LDS_BYTES = 131072;
constexpr float EPS = 1e-6f;
enum { I_X = 0, I_C, I_CTX, I_CCTX, I_ADAW, I_ADAB, I_N1G, I_N2G, I_WIN, I_LCW, I_LCB, I_LWA, I_LBA, I_LWX, I_LBX, I_LLAM,
       I_SCW, I_SCB, I_SDTB, I_SALOG, I_SD, I_SNG, I_WOUT, I_W1, I_W2, I_FG };

constexpr size_t WT_LAYER = 24117248ull;
constexpr size_t WT_WIN = 0, WT_WOUT = 5242880ull, WT_W1 = 7340032ull, WT_W2 = 15728640ull;
constexpr size_t WS_WT = 0;
constexpr size_t WS_MOD = 48234496ull;
constexpr size_t WS_CTX = 48676864ull;
constexpr size_t WS_H = 57065472ull;
constexpr size_t WS_PROJ = 94814208ull;
constexpr size_t WS_YD = 189186048ull;
constexpr size_t YD_ONE = 18874368ull;
constexpr size_t WS_DT = 264683520ull;
constexpr size_t WS_END = 265863168ull;
constexpr size_t WS_HID = WS_PROJ;

struct Args { const float* in[26]; float* out; unsigned char* ws; int ph_lo, ph_hi; };

__device__ __forceinline__ unsigned pk_bf16(float lo, float hi) { unsigned r; asm("v_cvt_pk_bf16_f32 %0, %1, %2" : "=v"(r) : "v"(lo), "v"(hi)); return r; }
__device__ __forceinline__ bf16_t to_bf16(float x) { return (bf16_t)(pk_bf16(x, 0.f) & 0xffffu); }
__device__ __forceinline__ float bf_lo(unsigned w) { return __uint_as_float(w << 16); }
__device__ __forceinline__ float bf_hi(unsigned w) { return __uint_as_float(w & 0xffff0000u); }
__device__ __forceinline__ float bf1(bf16_t h) { return __uint_as_float(((unsigned)h) << 16); }
__device__ __forceinline__ void unpack8(const u32x4 v, float (&f)[8]) {
    f[0] = bf_lo(v.x); f[1] = bf_hi(v.x); f[2] = bf_lo(v.y); f[3] = bf_hi(v.y);
    f[4] = bf_lo(v.z); f[5] = bf_hi(v.z); f[6] = bf_lo(v.w); f[7] = bf_hi(v.w);
}
__device__ __forceinline__ u32x4 pack8(const float (&f)[8]) {
    u32x4 w; w.x = pk_bf16(f[0], f[1]); w.y = pk_bf16(f[2], f[3]); w.z = pk_bf16(f[4], f[5]); w.w = pk_bf16(f[6], f[7]); return w;
}
__device__ __forceinline__ float sigmoid_f(float x) { return __builtin_amdgcn_rcpf(1.f + __expf(-x)); }
__device__ __forceinline__ float silu_f(float x) { return x * __builtin_amdgcn_rcpf(1.f + __expf(-x)); }
__device__ __forceinline__ float reduce16(const float (&p)[16], int lane) {
    const bool b5 = lane & 32, b4 = lane & 16, b3 = lane & 8, b2 = lane & 4; float q8[8], q4[4], q2[2];
#pragma unroll
    for (int k = 0; k < 8; ++k) { const float keep = b5 ? p[k + 8] : p[k], send = b5 ? p[k] : p[k + 8]; q8[k] = keep + __shfl_xor(send, 32); }
#pragma unroll
    for (int k = 0; k < 4; ++k) { const float keep = b4 ? q8[k + 4] : q8[k], send = b4 ? q8[k] : q8[k + 4]; q4[k] = keep + __shfl_xor(send, 16); }
#pragma unroll
    for (int k = 0; k < 2; ++k) { const float keep = b3 ? q4[k + 2] : q4[k], send = b3 ? q4[k] : q4[k + 2]; q2[k] = keep + __shfl_xor(send, 8); }
    const float keep = b2 ? q2[1] : q2[0], send = b2 ? q2[0] : q2[1]; float v = keep + __shfl_xor(send, 4);
    v += __shfl_xor(v, 2); v += __shfl_xor(v, 1); return v;
}
__device__ __forceinline__ float softplus_f(float x) { return x > 20.f ? x : log1pf(__expf(x)); }
__device__ __forceinline__ float wave_sum(float v) {
#pragma unroll
    for (int m = 32; m >= 1; m >>= 1) v += __shfl_xor(v, m);
    return v;
}

namespace pg8 {
constexpr int BM = 256, BK = 64, HALF = 128, HTB = HALF * BK * 2, STAGE_BYTES = 8 * HTB, NXCD = 8, WGM = 8;
__device__ __forceinline__ int lds_byte(int r, int c) { const int st = (r >> 4) * 2 + (c >> 5), rr = r & 15, cc = c & 31, ob = rr * 64 + cc * 2; return st * 1024 + (ob ^ (((ob >> 9) & 1) << 5)); }
__device__ __forceinline__ void stage_rc(int b, int& R, int& C) { const int st = b / 1024, sb = b % 1024, swz = sb ^ (((sb >> 9) & 1) << 5); R = (st >> 1) * 16 + swz / 64; C = (st & 1) * 32 + (swz % 64) / 2; }
__device__ __forceinline__ int perm32(int rho) { const int n = rho >> 4, i = rho & 15; return 8 * (i >> 2) + 4 * n + (i & 3); }
struct Unit { int pm, pn; };
struct Gemm { const bf16_t* A; const bf16_t* Bt; int M, N, K; };

struct Order {
    int nN, nlat, nctx, G, c;
    __device__ __forceinline__ void init(int nN_, int nNc, int G_, int c_) { nN = nN_; nlat = 64 * nN_; nctx = 8 * nNc; G = G_; c = c_; }
    __device__ __forceinline__ bool next(int i, Unit& u) const {
        long L = (long)i * G + c;
        if (L < nlat) {
            int wgid = (int)L; { const int q = nlat / NXCD, xcd = wgid % NXCD, off = wgid / NXCD; wgid = xcd * q + off; }
            const int nig = WGM * nN, gid = wgid / nig, fm = gid * WGM;
            u.pm = fm + ((wgid % nig) % WGM); u.pn = (wgid % nig) / WGM; return true;
        }
        L -= nlat; if (L >= nctx) return false;
        u.pm = 64 + (int)(L & 7); u.pn = (int)(L >> 3); return true;
    }
    __device__ __forceinline__ void a_ready(const Unit&) const {}
    __device__ __forceinline__ void done(const Unit&) const {}
};

template <int ACT  > struct EpiBf16 {
    static constexpr bool PERM = true;
    bf16_t* O; int ldc;
    __device__ __forceinline__ void operator()(const f32x4 (&acc)[2][2][4][2], const Unit& u, int wr, int wc, int fr, int fq) const {
        const int row0 = u.pm * BM + wr * 64 + fr, col0 = u.pn * BM + wc * 32 + 8 * fq;
#pragma unroll
        for (int ai = 0; ai < 2; ++ai)
#pragma unroll
            for (int m = 0; m < 4; ++m) { bf16_t* rowp = O + (size_t)(row0 + ai * HALF + m * 16) * ldc + col0;
#pragma unroll
                for (int bj = 0; bj < 2; ++bj) { f32x4 v0 = acc[ai][bj][m][0], v1 = acc[ai][bj][m][1];
                    if (ACT == 1) {
#pragma unroll
                        for (int j = 0; j < 4; ++j) { const float a = fmaxf(v0[j], 0.f), b = fmaxf(v1[j], 0.f); v0[j] = a * a; v1[j] = b * b; } }
                    u32x4 w; w.x = pk_bf16(v0[0], v0[1]); w.y = pk_bf16(v0[2], v0[3]); w.z = pk_bf16(v1[0], v1[1]); w.w = pk_bf16(v1[2], v1[3]);
                    *(u32x4*)(rowp + bj * HALF) = w; } }
    }
};
struct EpiGate {
    static constexpr bool PERM = false;
    const float* base_lat; float* out_lat; const float* base_ctx; float* out_ctx; const float* gate;
    __device__ __forceinline__ void operator()(const f32x4 (&acc)[2][2][4][2], const Unit& u, int wr, int wc, int fr, int fq) const {
        const int row0 = u.pm * BM + wr * 64 + fr, col0 = u.pn * BM + wc * 32 + 4 * fq;
        const bool isctx = u.pm >= 64; const int mrow = isctx ? 8 : (u.pm >> 3);
        const float* gp = gate + (size_t)mrow * 6144 + col0;
        const float* bp = isctx ? base_ctx - (size_t)NLAT * D : base_lat; float* op = isctx ? out_ctx - (size_t)NLAT * D : out_lat;
        f32x4 gv[2][2];
#pragma unroll
        for (int bj = 0; bj < 2; ++bj)
#pragma unroll
            for (int n = 0; n < 2; ++n) gv[bj][n] = *(const f32x4*)(gp + bj * HALF + n * 16);
#pragma unroll
        for (int ai = 0; ai < 2; ++ai)
#pragma unroll
            for (int m = 0; m < 4; ++m) { const size_t off = (size_t)(row0 + ai * HALF + m * 16) * D + col0;
#pragma unroll
                for (int bj = 0; bj < 2; ++bj)
#pragma unroll
                    for (int n = 0; n < 2; ++n) { const f32x4 bs = *(const f32x4*)(bp + off + bj * HALF + n * 16);
                        *(f32x4*)(op + off + bj * HALF + n * 16) = bs + gv[bj][n] * acc[ai][bj][m][n]; }
                asm volatile("" ::: "memory"); }
    }
};

template <class Epi, class Sched>
__device__ __forceinline__ void gemm_phase(lptr lds, const Gemm g, const Sched& S, const Epi& E, const int tid) {
    const int wid = __builtin_amdgcn_readfirstlane(tid >> 6), lane = tid & 63, wr = wid >> 2, wc = wid & 3, fr = lane & 15, fq = lane >> 4;
    const int K = g.K, nt = K / BK;
    unsigned voffA[2], voffB[2];
#pragma unroll
    for (int i = 0; i < 2; ++i) { int R, C; stage_rc(tid * 16 + i * 8192, R, C); const int Rb = Epi::PERM ? ((R & ~31) + perm32(R & 31)) : R;
        voffA[i] = (unsigned)(R * K + C) * 2u; voffB[i] = (unsigned)(Rb * K + C) * 2u; }
    const size_t kstep = (size_t)(BK * 2);
    const size_t hstep = (size_t)HALF * K * 2;
    const size_t tstep = 2 * hstep;
    const unsigned ldsw = (unsigned)wid * 1024u;
    const int aoff = lds_byte(wr * 64 + fr, fq * 8), boff = lds_byte(wc * 32 + fr, fq * 8);
#define PG8_SA(b, h) (((b) * 2 + (h)) * HTB)
#define PG8_SB(b, h) ((4 + (b) * 2 + (h)) * HTB)
#define PG8_STAGE(bufoff, gbase, voff) do { _Pragma("unroll") for (int _i = 0; _i < 2; ++_i) \
        __builtin_amdgcn_global_load_lds((const unsigned*)((const char*)(gbase) + (voff)[_i]), (LAS unsigned*)(lds + (bufoff) + ldsw + _i * 8192), 16, 0, 0); } while (0)
#define PG8_LDA(dst, b, h) do { _Pragma("unroll") for (int m = 0; m < 4; ++m) _Pragma("unroll") for (int k = 0; k < 2; ++k) dst[m][k] = *(const LAS bf16x8*)(lds + PG8_SA(b, h) + aoff + m * 2048 + k * 1024); } while (0)
#define PG8_LDB(dst, b, h) do { _Pragma("unroll") for (int n = 0; n < 2; ++n) _Pragma("unroll") for (int k = 0; k < 2; ++k) dst[n][k] = *(const LAS bf16x8*)(lds + PG8_SB(b, h) + boff + n * 2048 + k * 1024); } while (0)
#define PG8_MMA(ai, bj, At, Bt) do { __builtin_amdgcn_s_setprio(1); _Pragma("unroll") for (int m = 0; m < 4; ++m) _Pragma("unroll") for (int n = 0; n < 2; ++n) _Pragma("unroll") for (int k = 0; k < 2; ++k) \
        acc[ai][bj][m][n] = __builtin_amdgcn_mfma_f32_16x16x32_bf16(Bt[n][k], At[m][k], acc[ai][bj][m][n], 0, 0, 0); __builtin_amdgcn_s_setprio(0); } while (0)
#define PG8_WAIT_V(n) asm volatile("s_waitcnt vmcnt(" #n ")" ::: "memory")
#define PG8_WAIT_L(n) asm volatile("s_waitcnt lgkmcnt(" #n ")" ::: "memory")
#define PG8_BAR __builtin_amdgcn_s_barrier()
#define PG8_SCHED __builtin_amdgcn_sched_barrier(0)
    Unit cur, nxt; int ui = 0;
    if (!S.next(0, cur)) return;
    f32x4 acc[2][2][4][2];
#pragma unroll
    for (int a = 0; a < 2; ++a)
#pragma unroll
        for (int b = 0; b < 2; ++b)
#pragma unroll
            for (int m = 0; m < 4; ++m)
#pragma unroll
                for (int n = 0; n < 2; ++n) acc[a][b][m][n] = (f32x4){0.f, 0.f, 0.f, 0.f};
    bf16x8 At[4][2], B0[2][2], B1[2][2];
    const char* cA = (const char*)g.A + (size_t)cur.pm * tstep; const char* cB = (const char*)g.Bt + (size_t)cur.pn * tstep;
    S.a_ready(cur);
    PG8_STAGE(PG8_SB(0, 0), cB, voffB); PG8_STAGE(PG8_SA(0, 0), cA, voffA); PG8_STAGE(PG8_SB(0, 1), cB + hstep, voffB); PG8_STAGE(PG8_SA(0, 1), cA + hstep, voffA);
    if (wr == 1) PG8_BAR;
    PG8_WAIT_V(4); PG8_BAR;
    PG8_STAGE(PG8_SB(1, 0), cB + kstep, voffB); PG8_STAGE(PG8_SA(1, 0), cA + kstep, voffA); PG8_STAGE(PG8_SB(1, 1), cB + hstep + kstep, voffB);
    PG8_WAIT_V(6); PG8_BAR;
    for (;;) {
        const bool has_next = S.next(ui + 1, nxt);
        const char* nA = has_next ? (const char*)g.A + (size_t)nxt.pm * tstep : cA; const char* nB = has_next ? (const char*)g.Bt + (size_t)nxt.pn * tstep : cB;
        for (int t = 0; t < nt; t += 2) {
            const bool last = (t == nt - 2);
            const char* a1 = cA + (size_t)(t + 1) * kstep;
            const char* a2 = last ? nA : cA + (size_t)(t + 2) * kstep; const char* b2 = last ? nB : cB + (size_t)(t + 2) * kstep;
            const char* a3 = a2 + kstep; const char* b3 = b2 + kstep;
            if (last && has_next) S.a_ready(nxt);
            PG8_LDB(B0, 0, 0); PG8_SCHED; PG8_LDA(At, 0, 0); PG8_STAGE(PG8_SA(1, 1), a1 + hstep, voffA);
            PG8_WAIT_L(8); PG8_BAR; PG8_WAIT_L(0); PG8_MMA(0, 0, At, B0); PG8_BAR; PG8_SCHED;
            PG8_LDB(B1, 0, 1); PG8_STAGE(PG8_SB(0, 0), b2, voffB);
            PG8_BAR; PG8_WAIT_L(0); PG8_MMA(0, 1, At, B1); PG8_BAR;
            PG8_LDA(At, 0, 1); PG8_STAGE(PG8_SA(0, 0), a2, voffA);
            PG8_BAR; PG8_WAIT_L(0); PG8_MMA(1, 0, At, B0); PG8_BAR; PG8_SCHED;
            PG8_STAGE(PG8_SB(0, 1), b2 + hstep, voffB);
            PG8_WAIT_V(6); PG8_BAR; PG8_MMA(1, 1, At, B1); PG8_BAR;
            PG8_LDB(B0, 1, 0); PG8_SCHED; PG8_LDA(At, 1, 0); PG8_STAGE(PG8_SA(0, 1), a2 + hstep, voffA);
            PG8_WAIT_L(8); PG8_BAR; PG8_WAIT_L(0); PG8_MMA(0, 0, At, B0); PG8_BAR; PG8_SCHED;
            PG8_LDB(B1, 1, 1); PG8_STAGE(PG8_SB(1, 0), b3, voffB);
            PG8_BAR; PG8_WAIT_L(0); PG8_MMA(0, 1, At, B1); PG8_BAR;
            PG8_LDA(At, 1, 1); PG8_STAGE(PG8_SA(1, 0), a3, voffA);
            PG8_BAR; PG8_WAIT_L(0); PG8_MMA(1, 0, At, B0); PG8_BAR; PG8_SCHED;
            PG8_STAGE(PG8_SB(1, 1), b3 + hstep, voffB);
            PG8_WAIT_V(6); PG8_BAR; PG8_MMA(1, 1, At, B1); PG8_BAR;
        }
        E(acc, cur, wr, wc, fr, fq); S.done(cur);
        if (!has_next) break;
#pragma unroll
        for (int a = 0; a < 2; ++a)
#pragma unroll
            for (int b = 0; b < 2; ++b)
#pragma unroll
                for (int m = 0; m < 4; ++m)
#pragma unroll
                    for (int n = 0; n < 2; ++n) acc[a][b][m][n] = (f32x4){0.f, 0.f, 0.f, 0.f};
        cur = nxt; cA = nA; cB = nB; ++ui;
    }
    PG8_WAIT_V(0);
    if (wr == 0) PG8_BAR;
    PG8_BAR;
#undef PG8_SA
#undef PG8_SB
#undef PG8_STAGE
#undef PG8_LDA
#undef PG8_LDB
#undef PG8_MMA
#undef PG8_WAIT_V
#undef PG8_WAIT_L
#undef PG8_BAR
#undef PG8_SCHED
}
}

__device__ __forceinline__ void mod_unit(const Args& a, int u, lptr lds, const int tid) {
    LAS float* sl = (LAS float*)lds;
    LAS float* red = sl + 9 * 1024;
    for (int i = tid; i < 9 * 1024; i += NTHREADS) { const int r = i >> 10, k = i & 1023; const float v = r < 8 ? a.in[I_C][r * 1024 + k] : a.in[I_CCTX][k]; sl[i] = v / (1.f + __expf(-v)); }
    __syncthreads();
    const int l = u / 96, jb = u % 96, col = tid & 63, kq = tid >> 6;
    const float* w = a.in[I_ADAW] + (size_t)l * 1024 * 6144 + jb * 64 + col;
    float acc[9];
#pragma unroll
    for (int r = 0; r < 9; ++r) acc[r] = 0.f;
    for (int k = kq * 128; k < kq * 128 + 128; k += 16) {
        float wv[16];
#pragma unroll
        for (int e = 0; e < 16; ++e) wv[e] = w[(size_t)(k + e) * 6144];
#pragma unroll
        for (int r = 0; r < 9; ++r)
#pragma unroll
            for (int e4 = 0; e4 < 4; ++e4) { const f32x4 sv = *(const LAS f32x4*)(sl + r * 1024 + k + e4 * 4); acc[r] += sv[0] * wv[e4 * 4] + sv[1] * wv[e4 * 4 + 1] + sv[2] * wv[e4 * 4 + 2] + sv[3] * wv[e4 * 4 + 3]; }
    }
#pragma unroll
    for (int r = 0; r < 9; ++r) red[(kq * 9 + r) * 64 + col] = acc[r];
    __syncthreads();
    float* mod = (float*)(a.ws + WS_MOD);
    if (tid < 64) {
        const float bias = a.in[I_ADAB][l * 6144 + jb * 64 + tid];
#pragma unroll
        for (int r = 0; r < 9; ++r) { float v = bias;
#pragma unroll
            for (int q = 0; q < 8; ++q) v += red[(q * 9 + r) * 64 + tid];
            mod[(size_t)(l * 9 + r) * 6144 + jb * 64 + tid] = v; }
    }
    __syncthreads();
}
struct CvtTile { const float* src; bf16_t* dst; int ld, K; };
__device__ __forceinline__ CvtTile cvt_decode(const Args& a, int t) {
    const int l = t / 2944; int tt = t % 2944;
    const float* src; int ld, c0, K, n0; bf16_t* dst; bf16_t* wt = (bf16_t*)(a.ws + WS_WT + (size_t)l * WT_LAYER);
    if (tt < 384)       { src = a.in[I_WIN] + (size_t)l * 1024 * 2576; ld = 2576; c0 = 0; K = 1024; n0 = 0; dst = wt + WT_WIN / 2; }
    else if (tt < 640)  { tt -= 384; src = a.in[I_WIN] + (size_t)l * 1024 * 2576; ld = 2576; c0 = 1552; K = 1024; n0 = 1536; dst = wt + WT_WIN / 2; }
    else if (tt < 896)  { tt -= 640; src = a.in[I_WOUT] + (size_t)l * 1024 * 1024; ld = 1024; c0 = 0; K = 1024; n0 = 0; dst = wt + WT_WOUT / 2; }
    else if (tt < 1920) { tt -= 896; src = a.in[I_W1] + (size_t)l * 1024 * 4096; ld = 4096; c0 = 0; K = 1024; n0 = 0; dst = wt + WT_W1 / 2; }
    else                { tt -= 1920; src = a.in[I_W2] + (size_t)l * 4096 * 1024; ld = 1024; c0 = 0; K = 4096; n0 = 0; dst = wt + WT_W2 / 2; }
    const int nk = K / 64, kt = tt % nk, ntile = tt / nk;
    CvtTile c; c.src = src + (size_t)(kt * 64) * ld + c0 + ntile * 64; c.dst = dst + (size_t)(n0 + ntile * 64) * K + kt * 64; c.ld = ld; c.K = K; return c;
}
__device__ __forceinline__ void phase_prep(const Args& a, lptr lds, const int tid, const int bid) {
    for (int u = bid; u < 192; u += gridDim.x) mod_unit(a, u, lds, tid);
    LAS float* T = (LAS float*)lds;
    const int G = gridDim.x, r = tid >> 4, c4 = (tid & 15) * 4, n = tid >> 3, k8 = (tid & 7) * 8;
    for (int t0 = bid; t0 < 2 * 2944; t0 += 4 * G) {
        f32x4 ldv[4][2];
#pragma unroll
        for (int q = 0; q < 4; ++q) { const int t = t0 + q * G;
            if (t < 2 * 2944) { const CvtTile c = cvt_decode(a, t);
#pragma unroll
                for (int i = 0; i < 2; ++i) ldv[q][i] = *(const f32x4*)(c.src + (size_t)(r + 32 * i) * c.ld + c4); }
            else { ldv[q][0] = (f32x4){0.f, 0.f, 0.f, 0.f}; ldv[q][1] = ldv[q][0]; } }
#pragma unroll
        for (int q = 0; q < 4; ++q)
#pragma unroll
            for (int i = 0; i < 2; ++i) { LAS float* tp = T + q * 4160 + (r + 32 * i) * 65 + c4; tp[0] = ldv[q][i][0]; tp[1] = ldv[q][i][1]; tp[2] = ldv[q][i][2]; tp[3] = ldv[q][i][3]; }
        __syncthreads();
#pragma unroll
        for (int q = 0; q < 4; ++q) { const int t = t0 + q * G;
            if (t < 2 * 2944) { const CvtTile c = cvt_decode(a, t); float f[8];
#pragma unroll
                for (int e = 0; e < 8; ++e) f[e] = T[q * 4160 + (k8 + e) * 65 + n];
                *(u32x4*)(c.dst + (size_t)n * c.K + k8) = pack8(f); } }
        __syncthreads();
    }
}

__device__ __forceinline__ void phase_norm(const Args& a, int l, int which, int nrows, const float* xlat, const float* xctx, lptr lds, const int tid, const int bid) {
    const int lane = tid & 63, wave = tid >> 6;
    const float* g = a.in[which ? I_N2G : I_N1G] + l * 1024;
    const float* mod = (const float*)(a.ws + WS_MOD) + (size_t)l * 9 * 6144 + (which ? 3072 : 0);
    bf16_t* hb = (bf16_t*)(a.ws + WS_H);
    float* dtb = (float*)(a.ws + WS_DT);
    LAS float* Wdt = (LAS float*)lds;
    if (which == 0) {
        const float* win = a.in[I_WIN] + (size_t)l * 1024 * 2576 + 1536;
        for (int i = tid; i < 4096; i += NTHREADS) { const int c = i >> 2, j4 = (i & 3) * 4; const f32x4 w = *(const f32x4*)(win + (size_t)c * 2576 + j4);
            Wdt[(j4 + 0) * 1024 + c] = w[0]; Wdt[(j4 + 1) * 1024 + c] = w[1]; Wdt[(j4 + 2) * 1024 + c] = w[2]; Wdt[(j4 + 3) * 1024 + c] = w[3]; }
        __syncthreads();
    }
    const int GW = gridDim.x * 8, gw = bid * 8 + wave;
    for (int r0 = gw; r0 < nrows; r0 += 3 * GW) {
        f32x4 v[3][4]; float rstd[3];
#pragma unroll
        for (int r = 0; r < 3; ++r) { const int row = r0 + r * GW, rr = row < nrows ? row : r0;
            const float* xr = rr < NLAT ? xlat + (size_t)rr * D : xctx + (size_t)(rr - NLAT) * D;
#pragma unroll
            for (int i = 0; i < 4; ++i) v[r][i] = *(const f32x4*)(xr + lane * 4 + 256 * i); }
#pragma unroll
        for (int r = 0; r < 3; ++r) { float ss = 0.f;
#pragma unroll
            for (int i = 0; i < 4; ++i) ss += v[r][i][0] * v[r][i][0] + v[r][i][1] * v[r][i][1] + v[r][i][2] * v[r][i][2] + v[r][i][3] * v[r][i][3];
            ss = wave_sum(ss); rstd[r] = rsqrtf(ss * (1.f / 1024.f) + EPS); }
#pragma unroll
        for (int r = 0; r < 3; ++r) { const int row = r0 + r * GW, rr = row < nrows ? row : r0;
            const float* mr = mod + (size_t)(rr < NLAT ? (rr >> 11) : 8) * 6144;
#pragma unroll
            for (int i = 0; i < 4; ++i) { const int c = lane * 4 + 256 * i;
                const f32x4 gg = *(const f32x4*)(g + c), sh = *(const f32x4*)(mr + c), sc = *(const f32x4*)(mr + 1024 + c);
                v[r][i] = (v[r][i] * rstd[r] * gg) * (sc + 1.f) + sh;
                u32x2 w; w.x = pk_bf16(v[r][i][0], v[r][i][1]); w.y = pk_bf16(v[r][i][2], v[r][i][3]);
                if (row < nrows) *(u32x2*)(hb + (size_t)row * D + c) = w; } }
        if (which == 0) {
            const int jidx = ((lane >> 5) & 1) * 8 + ((lane >> 4) & 1) * 4 + ((lane >> 3) & 1) * 2 + ((lane >> 2) & 1);
#pragma unroll
            for (int r = 0; r < 3; ++r) { const int row = r0 + r * GW; float p[16];
#pragma unroll
                for (int j = 0; j < 16; ++j) { float acc = 0.f;
#pragma unroll
                    for (int i = 0; i < 4; ++i) { const f32x4 w = *(const LAS f32x4*)(Wdt + j * 1024 + lane * 4 + 256 * i); acc += v[r][i][0] * w[0] + v[r][i][1] * w[1] + v[r][i][2] * w[2] + v[r][i][3] * w[3]; }
                    p[j] = acc; }
                const float val = reduce16(p, lane);
                if ((lane & 3) == 0 && row < nrows) dtb[(size_t)row * 16 + jidx] = val;
                asm volatile("" ::: "memory"); }
        }
    }
}

__device__ __forceinline__ void phase_conv(const Args& a, int l, const int tid, const int bid) {
    const int v = tid & 127, rsub = tid >> 7;
    const bf16_t* proj = (const bf16_t*)(a.ws + WS_PROJ);
    bf16_t* xc = (bf16_t*)(a.ws + WS_H);
    float cw[4][8], cb[8];
    const float* cwp = a.in[I_SCW] + (size_t)l * 4 * 1024 + v * 8; const float* cbp = a.in[I_SCB] + (size_t)l * 1024 + v * 8;
#pragma unroll
    for (int k = 0; k < 4; ++k)
#pragma unroll
        for (int e = 0; e < 8; ++e) cw[k][e] = cwp[k * 1024 + e];
#pragma unroll
    for (int e = 0; e < 8; ++e) cb[e] = cbp[e];
    const int step = gridDim.x * 4;
    for (int o0 = bid * 4 + rsub; o0 < NROW; o0 += 3 * step) {
        u32x4 rv[3][4];
#pragma unroll
        for (int r = 0; r < 3; ++r) { const int oo = o0 + r * step, o = oo < NROW ? oo : o0;
            const bool isctx = o >= NLAT; const int b = isctx ? (o - NLAT) >> 8 : o >> 11; const int pos = isctx ? (o - NLAT) & 255 : o & 2047; const int len = isctx ? 256 : 2048;
#pragma unroll
            for (int k = 0; k < 4; ++k) { const int p = pos + k - 1;
                if (p >= 0 && p < len) { const size_t srow = isctx ? (size_t)(NLAT + b * 256 + p) : (size_t)(b * 2048 + (p & 31) * 64 + (p >> 5));
                    rv[r][k] = *(const u32x4*)(proj + srow * NPROJ + 512 + v * 8); }
                else rv[r][k] = (u32x4){0u, 0u, 0u, 0u}; } }
#pragma unroll
        for (int r = 0; r < 3; ++r) { const int oo = o0 + r * step; float acc[8];
#pragma unroll
            for (int e = 0; e < 8; ++e) acc[e] = cb[e];
#pragma unroll
            for (int k = 0; k < 4; ++k) { float f[8]; unpack8(rv[r][k], f);
#pragma unroll
                for (int e = 0; e < 8; ++e) acc[e] += cw[k][e] * f[e]; }
#pragma unroll
            for (int e = 0; e < 8; ++e) acc[e] = silu_f(acc[e]);
            if (oo < NROW) *(u32x4*)(xc + (size_t)oo * 1024 + v * 8) = pack8(acc); }
    }
}

__device__ __forceinline__ void lru_load(const bf16_t* proj, int st, int b, int d, int head, int tid, u32x4 (&raw)[4]) {
    const bool isctx = st < 4; const int k = isctx ? st : st - 4, nblk = isctx ? 4 : 32, len = isctx ? 256 : 2048, rowbase = isctx ? NLAT + b * 256 : b * 2048;
    const int blk = d ? nblk - 1 - k : k, s = tid >> 3, cg8 = tid & 7; const int pos = d ? blk * 64 + 63 - s : blk * 64 + s;
#pragma unroll
    for (int kk = 0; kk < 4; ++kk) { const int p = pos + kk - 1;
        raw[kk] = (p >= 0 && p < len) ? *(const u32x4*)(proj + (size_t)(rowbase + p) * NPROJ + head * 64 + cg8 * 8) : (u32x4){0u, 0u, 0u, 0u}; }
}
__device__ __forceinline__ void lru_unit(const Args& a, int l, int b, int d, int head, bool ctx_out, lptr lds, const int tid) {
    const int lane = tid & 63, wave = tid >> 6, quad = lane >> 4, r16 = lane & 15;
    LAS bf16_t* WaT = (LAS bf16_t*)lds;
    LAS bf16_t* WxT = WaT + 64 * 72;
    LAS bf16_t* ub = WxT + 64 * 72;
    LAS float* uf = (LAS float*)(lds + 3 * 64 * 72 * 2);
    LAS float* av = uf + 4096; LAS float* bv = av + 4096;
    LAS float* sumA = bv + 4096; LAS float* sumH = sumA + 512; LAS float* carry = sumH + 512;
    const bf16_t* proj = (const bf16_t*)(a.ws + WS_PROJ);
    bf16_t* yout = (bf16_t*)(a.ws + WS_YD + (size_t)d * YD_ONE);
    {
        const float* wa = a.in[I_LWA] + ((((size_t)l * 2 + d) * 8 + head) * 4096); const float* wx = a.in[I_LWX] + ((((size_t)l * 2 + d) * 8 + head) * 4096);
        for (int idx = tid; idx < 4096; idx += NTHREADS) { const int i = idx >> 6, j = idx & 63; WaT[j * 72 + i] = to_bf16(wa[idx]); WxT[j * 72 + i] = to_bf16(wx[idx]); }
        if (tid < 128) carry[tid] = 0.f;
    }
    const int cg8 = tid & 7;
    float cw[4][8], cb[8];
    {
        const float* cwp = a.in[I_LCW] + (size_t)l * 4 * 512 + head * 64 + cg8 * 8; const float* cbp = a.in[I_LCB] + (size_t)l * 512 + head * 64 + cg8 * 8;
#pragma unroll
        for (int k = 0; k < 4; ++k)
#pragma unroll
            for (int e = 0; e < 8; ++e) cw[k][e] = cwp[k * 512 + e];
#pragma unroll
        for (int e = 0; e < 8; ++e) cb[e] = cbp[e];
    }
    const int tr = wave & 3, chb0 = (wave >> 2) * 2;
    float ba_v[2], bx_v[2], sp_v[2];
#pragma unroll
    for (int q = 0; q < 2; ++q) { const int gch = (l * 2 + d) * 512 + head * 64 + (chb0 + q) * 16 + r16;
        ba_v[q] = a.in[I_LBA][gch]; bx_v[q] = a.in[I_LBX][gch]; sp_v[q] = -8.f * softplus_f(-a.in[I_LLAM][gch]); }
    u32x4 raw[4];
    lru_load(proj, 0, b, d, head, tid, raw);
    for (int st = 0; st < 36; ++st) {
        const bool isctx = st < 4; const int k = isctx ? st : st - 4, nblk = isctx ? 4 : 32, rowbase = isctx ? NLAT + b * 256 : b * 2048;
        const int blk = d ? nblk - 1 - k : k;
        {
            float u[8];
#pragma unroll
            for (int e = 0; e < 8; ++e) u[e] = cb[e];
#pragma unroll
            for (int kk = 0; kk < 4; ++kk) { float f[8]; unpack8(raw[kk], f);
#pragma unroll
                for (int e = 0; e < 8; ++e) u[e] += cw[kk][e] * f[e]; }
            const int s = tid >> 3;
            *(LAS f32x4*)(uf + s * 64 + cg8 * 8) = (f32x4){u[0], u[1], u[2], u[3]}; *(LAS f32x4*)(uf + s * 64 + cg8 * 8 + 4) = (f32x4){u[4], u[5], u[6], u[7]};
            *(LAS u32x4*)(ub + s * 72 + cg8 * 8) = pack8(u);
        }
        if (st + 1 < 36) lru_load(proj, st + 1, b, d, head, tid, raw);
        __syncthreads();
#pragma unroll
        for (int q = 0; q < 2; ++q) {
            const int chb = chb0 + q; f32x4 ar = (f32x4){0.f, 0.f, 0.f, 0.f}, ai = ar;
#pragma unroll
            for (int kk = 0; kk < 2; ++kk) {
                const bf16x8 af = *(const LAS bf16x8*)(ub + (tr * 16 + r16) * 72 + kk * 32 + quad * 8);
                const bf16x8 br = *(const LAS bf16x8*)(WaT + (chb * 16 + r16) * 72 + kk * 32 + quad * 8);
                const bf16x8 bi = *(const LAS bf16x8*)(WxT + (chb * 16 + r16) * 72 + kk * 32 + quad * 8);
                ar = __builtin_amdgcn_mfma_f32_16x16x32_bf16(af, br, ar, 0, 0, 0);
                ai = __builtin_amdgcn_mfma_f32_16x16x32_bf16(af, bi, ai, 0, 0, 0);
            }
            const int ch = chb * 16 + r16;
#pragma unroll
            for (int j = 0; j < 4; ++j) { const int s = tr * 16 + quad * 4 + j;
                const float r = sigmoid_f(ar[j] + ba_v[q]), ii = sigmoid_f(ai[j] + bx_v[q]);
                const float la = sp_v[q] * r; const float aa = __expf(la); const float x2 = 2.f * la;
                const float mm = __builtin_amdgcn_sqrtf(fmaxf(-x2 * (1.f + x2 * (0.5f + x2 * (0.16666667f + x2 * (0.041666668f + x2 * (0.0083333338f + x2 * 0.0013888889f))))), 0.f));
                av[s * 64 + ch] = aa; bv[s * 64 + ch] = mm * ii * uf[s * 64 + ch]; }
        }
        __syncthreads();
        float hl[8], Al[8];
        { float h = 0.f, A = 1.f;
#pragma unroll
            for (int t = 0; t < 8; ++t) { const float aa = av[(wave * 8 + t) * 64 + lane], bb = bv[(wave * 8 + t) * 64 + lane]; h = aa * h + bb; A *= aa; hl[t] = h; Al[t] = A; }
            sumA[wave * 64 + lane] = A; sumH[wave * 64 + lane] = h; }
        __syncthreads();
        float c = carry[(st & 1) * 64 + lane];
#pragma unroll
        for (int q = 0; q < 8; ++q) if (q < wave) c = sumA[q * 64 + lane] * c + sumH[q * 64 + lane];
        const bool store = !isctx || ctx_out;
#pragma unroll
        for (int t = 0; t < 8; ++t) { const float hf = hl[t] + Al[t] * c; const int s = wave * 8 + t; const int pos = d ? blk * 64 + 63 - s : blk * 64 + s;
            if (store) yout[(size_t)(rowbase + pos) * 512 + head * 64 + lane] = to_bf16(hf);
            if (t == 7 && wave == 7) carry[((st + 1) & 1) * 64 + lane] = hf; }
    }
    __syncthreads();
}

__device__ __forceinline__ void ssd_load(const bf16_t* xc, const float* dtb, int st, int b, int d, int h, int tid, u32x4 (&rr)[5], float& dtr) {
    const bool isctx = st < 4; const int k = isctx ? st : st - 4, nblk = isctx ? 4 : 32; const int blk = d ? nblk - 1 - k : k, base = blk * 64;
    const size_t orow0 = (size_t)(isctx ? NLAT + b * 256 : b * 2048) + base; const int g = h >> 2;
#pragma unroll
    for (int i = 0; i < 4; ++i) { const int q = tid + 512 * (i & 1), lq = q >> 4, v = q & 15; const int prow = d ? 63 - lq : lq;
        rr[i] = *(const u32x4*)(xc + (orow0 + prow) * 1024 + (i < 2 ? 512 : 768) + g * 128 + v * 8); }
    { const int lq = tid >> 3, v = tid & 7; const int prow = d ? 63 - lq : lq; rr[4] = *(const u32x4*)(xc + (orow0 + prow) * 1024 + h * 64 + v * 8); }
    if (tid < 64) { const int pos = base + (d ? 63 - tid : tid); const size_t grow = isctx ? (size_t)(NLAT + b * 256 + pos) : (size_t)(b * 2048 + (pos & 31) * 64 + (pos >> 5));
        dtr = dtb[grow * 16 + d * 8 + h]; }
}
__device__ __forceinline__ void ssd_unit(const Args& a, int l, int b, int d, int h, bool ctx_out, lptr lds, const int tid) {
    const int lane = tid & 63, wave = tid >> 6, quad = lane >> 4, r16 = lane & 15;
    LAS bf16_t* Cs = (LAS bf16_t*)lds;
    LAS bf16_t* Bs = Cs + 64 * 136;
    LAS bf16_t* BT = Bs + 64 * 136;
    LAS bf16_t* XT = BT + 128 * 72;
    LAS bf16_t* Xr = XT + 64 * 72;
    LAS bf16_t* Ms = Xr + 64 * 72;
    LAS bf16_t* Sb = Ms + 64 * 72;
    LAS float* acs = (LAS float*)(Sb + 64 * 136);
    LAS float* dtv = acs + 64;
    const bf16_t* xc = (const bf16_t*)(a.ws + WS_H);
    const float* dtb = (const float*)(a.ws + WS_DT);
    bf16_t* yout = (bf16_t*)(a.ws + WS_YD + (size_t)(2 + d) * YD_ONE);
    const float dt_bias = a.in[I_SDTB][(l * 2 + d) * 8 + h], negA = -__expf(a.in[I_SALOG][(l * 2 + d) * 8 + h]), Dh = (d == 0) ? a.in[I_SD][l * 8 + h] : 0.f;
    for (int i = tid; i < 64 * 136 / 2; i += NTHREADS) ((LAS unsigned*)Sb)[i] = 0u;
    f32x4 Sacc[4];
#pragma unroll
    for (int q = 0; q < 4; ++q) Sacc[q] = (f32x4){0.f, 0.f, 0.f, 0.f};
    u32x4 rr[5]; float dtr = 0.f;
    ssd_load(xc, dtb, 0, b, d, h, tid, rr, dtr);
    for (int st = 0; st < 36; ++st) {
        const bool isctx = st < 4; const int k = isctx ? st : st - 4, nblk = isctx ? 4 : 32; const int blk = d ? nblk - 1 - k : k, base = blk * 64;
#pragma unroll
        for (int i = 0; i < 4; ++i) { const int q = tid + 512 * (i & 1), lq = q >> 4, v = q & 15; *(LAS u32x4*)((i < 2 ? Bs : Cs) + lq * 136 + v * 8) = rr[i]; }
        { const int lq = tid >> 3, v = tid & 7; *(LAS u32x4*)(Xr + lq * 72 + v * 8) = rr[4]; }
        if (wave == 0) {
            const float dt = softplus_f(dtr + dt_bias); float cs = dt * negA;
#pragma unroll
            for (int off = 1; off < 64; off <<= 1) { const float t = __shfl_up(cs, off); if (lane >= off) cs += t; }
            acs[lane] = cs; dtv[lane] = dt;
        }
        __syncthreads();
        if (st + 1 < 36) ssd_load(xc, dtb, st + 1, b, d, h, tid, rr, dtr);
        const float alast = acs[63];
#pragma unroll
        for (int i = 0; i < 3; ++i) { const int lq = lane, v = wave + 8 * i;
            if (i == 0) { const u32x4 xv = *(const LAS u32x4*)(Xr + lq * 72 + v * 8); float f[8]; unpack8(xv, f); const float s = dtv[lq];
#pragma unroll
                for (int e = 0; e < 8; ++e) XT[(v * 8 + e) * 72 + lq] = to_bf16(f[e] * s); }
            else { const int vb = v - 8; const u32x4 bvv = *(const LAS u32x4*)(Bs + lq * 136 + vb * 8); float f[8]; unpack8(bvv, f); const float s = __expf(alast - acs[lq]);
#pragma unroll
                for (int e = 0; e < 8; ++e) BT[(vb * 8 + e) * 72 + lq] = to_bf16(f[e] * s); } }
        { const int tl = wave & 3, ts0 = (wave >> 2) * 2;
#pragma unroll
          for (int q = 0; q < 2; ++q) { const int ts = ts0 + q; f32x4 acc = (f32x4){0.f, 0.f, 0.f, 0.f};
            if (ts <= tl) {
#pragma unroll
                for (int kk = 0; kk < 4; ++kk) { const bf16x8 af = *(const LAS bf16x8*)(Cs + (tl * 16 + r16) * 136 + kk * 32 + quad * 8); const bf16x8 bf = *(const LAS bf16x8*)(Bs + (ts * 16 + r16) * 136 + kk * 32 + quad * 8);
                    acc = __builtin_amdgcn_mfma_f32_16x16x32_bf16(bf, af, acc, 0, 0, 0); } }
            const int ll = tl * 16 + r16; const float al = acs[ll]; float m[4];
#pragma unroll
            for (int j = 0; j < 4; ++j) { const int s = ts * 16 + quad * 4 + j; m[j] = (s <= ll) ? acc[j] * __expf(al - acs[s]) : 0.f; }
            u32x2 w; w.x = pk_bf16(m[0], m[1]); w.y = pk_bf16(m[2], m[3]); *(LAS u32x2*)(Ms + ll * 72 + ts * 16 + quad * 4) = w; } }
        __syncthreads();
        if (!isctx || ctx_out) { const int tl = wave & 3, tp0 = (wave >> 2) * 2; const int ll = tl * 16 + r16; const float ea = __expf(acs[ll]);
            const int pos = base + (d ? 63 - ll : ll); const size_t grow = isctx ? (size_t)(NLAT + b * 256 + pos) : (size_t)(b * 2048 + (pos & 31) * 64 + (pos >> 5));
#pragma unroll
            for (int q = 0; q < 2; ++q) { const int tp = tp0 + q; f32x4 a1 = (f32x4){0.f, 0.f, 0.f, 0.f}, a2 = a1;
#pragma unroll
                for (int kk = 0; kk < 2; ++kk) { const bf16x8 af = *(const LAS bf16x8*)(Ms + (tl * 16 + r16) * 72 + kk * 32 + quad * 8); const bf16x8 bf = *(const LAS bf16x8*)(XT + (tp * 16 + r16) * 72 + kk * 32 + quad * 8);
                    a1 = __builtin_amdgcn_mfma_f32_16x16x32_bf16(bf, af, a1, 0, 0, 0); }
#pragma unroll
                for (int kk = 0; kk < 4; ++kk) { const bf16x8 af = *(const LAS bf16x8*)(Cs + (tl * 16 + r16) * 136 + kk * 32 + quad * 8); const bf16x8 bf = *(const LAS bf16x8*)(Sb + (tp * 16 + r16) * 136 + kk * 32 + quad * 8);
                    a2 = __builtin_amdgcn_mfma_f32_16x16x32_bf16(bf, af, a2, 0, 0, 0); }
                const u32x2 xv = *(const LAS u32x2*)(Xr + ll * 72 + tp * 16 + quad * 4);
                const float y0 = a1[0] + ea * a2[0] + Dh * bf_lo(xv.x), y1 = a1[1] + ea * a2[1] + Dh * bf_hi(xv.x), y2 = a1[2] + ea * a2[2] + Dh * bf_lo(xv.y), y3 = a1[3] + ea * a2[3] + Dh * bf_hi(xv.y);
                u32x2 w; w.x = pk_bf16(y0, y1); w.y = pk_bf16(y2, y3); *(u32x2*)(yout + grow * 512 + h * 64 + tp * 16 + quad * 4) = w; } }
        { const int tp = wave & 3, tn0 = (wave >> 2) * 4; const float eal = __expf(alast);
#pragma unroll
          for (int q = 0; q < 4; ++q) { const int tn = tn0 + q; Sacc[q] = Sacc[q] * eal;
#pragma unroll
            for (int kk = 0; kk < 2; ++kk) { const bf16x8 af = *(const LAS bf16x8*)(XT + (tp * 16 + r16) * 72 + kk * 32 + quad * 8); const bf16x8 bf = *(const LAS bf16x8*)(BT + (tn * 16 + r16) * 72 + kk * 32 + quad * 8);
                Sacc[q] = __builtin_amdgcn_mfma_f32_16x16x32_bf16(bf, af, Sacc[q], 0, 0, 0); } } }
        __syncthreads();
        { const int tp = wave & 3, tn0 = (wave >> 2) * 4;
#pragma unroll
          for (int q = 0; q < 4; ++q) { u32x2 w; w.x = pk_bf16(Sacc[q][0], Sacc[q][1]); w.y = pk_bf16(Sacc[q][2], Sacc[q][3]); *(LAS u32x2*)(Sb + (tp * 16 + r16) * 136 + (tn0 + q) * 16 + quad * 4) = w; } }
    }
    __syncthreads();
}
__device__ __forceinline__ void phase_scan(const Args& a, int l, lptr lds, const int tid, const int bid) {
    const bool ctx_out = (l == 0);
    for (int u = bid; u < 256; u += gridDim.x) {
        const int kind = u & 1, r = u >> 1, b = r & 7, d = (r >> 3) & 1, hh = r >> 4;
        if (kind == 0) lru_unit(a, l, b, d, hh, ctx_out, lds, tid); else ssd_unit(a, l, b, d, hh, ctx_out, lds, tid);
    }
}

__device__ __forceinline__ void phase_combine(const Args& a, int l, int nrows, const int tid, const int bid) {
    const int lane = tid & 63, wave = tid >> 6, c8 = lane * 8;
    const bf16_t* proj = (const bf16_t*)(a.ws + WS_PROJ);
    const bf16_t* y0 = (const bf16_t*)(a.ws + WS_YD); const bf16_t* y1 = y0 + YD_ONE / 2; const bf16_t* s0 = y1 + YD_ONE / 2; const bf16_t* s1 = s0 + YD_ONE / 2;
    bf16_t* cat = (bf16_t*)(a.ws + WS_H);
    float gn[8];
#pragma unroll
    for (int e = 0; e < 8; ++e) gn[e] = a.in[I_SNG][l * 512 + c8 + e];
    const int GW = gridDim.x * 8, gw = bid * 8 + wave;
    for (int r0 = gw; r0 < nrows; r0 += 3 * GW) {
        u32x4 va[3], vb[3], vg[3], vs0[3], vs1[3], vz[3];
#pragma unroll
        for (int r = 0; r < 3; ++r) { const int row = r0 + r * GW; const size_t rr = row < nrows ? row : r0;
            va[r] = *(const u32x4*)(y0 + rr * 512 + c8); vb[r] = *(const u32x4*)(y1 + rr * 512 + c8); vg[r] = *(const u32x4*)(proj + rr * NPROJ + 1536 + c8);
            vs0[r] = *(const u32x4*)(s0 + rr * 512 + c8); vs1[r] = *(const u32x4*)(s1 + rr * 512 + c8); vz[r] = *(const u32x4*)(proj + rr * NPROJ + 2048 + c8); }
#pragma unroll
        for (int r = 0; r < 3; ++r) { const int row = r0 + r * GW; const bool ok = row < nrows;
            float fa[8], fb[8], fg[8], o[8];
            unpack8(va[r], fa); unpack8(vb[r], fb); unpack8(vg[r], fg);
#pragma unroll
            for (int e = 0; e < 8; ++e) { const float x = fg[e]; const float t = 1.5957691216057308f * (x + 0.044715f * x * x * x); o[e] = (fa[e] + fb[e]) * (x * sigmoid_f(t)); }
            if (ok) *(u32x4*)(cat + (size_t)row * D + c8) = pack8(o);
            unpack8(vs0[r], fa); unpack8(vs1[r], fb); unpack8(vz[r], fg);
            float ss = 0.f;
#pragma unroll
            for (int e = 0; e < 8; ++e) { o[e] = (fa[e] + fb[e]) * silu_f(fg[e]); ss += o[e] * o[e]; }
#pragma unroll
            for (int m = 16; m >= 1; m >>= 1) ss += __shfl_xor(ss, m);
            const float rs = rsqrtf(ss * (1.f / 256.f) + EPS);
#pragma unroll
            for (int e = 0; e < 8; ++e) o[e] = o[e] * rs * gn[e];
            if (ok) *(u32x4*)(cat + (size_t)row * D + 512 + c8) = pack8(o); }
    }
}

__device__ __forceinline__ void phase_final(const Args& a, const int tid, const int bid) {
    const int lane = tid & 63, wave = tid >> 6;
    const float* g = a.in[I_FG];
    const int GW = gridDim.x * 8, gw = bid * 8 + wave;
    for (int r0 = gw; r0 < NLAT; r0 += 4 * GW) {
        f32x4 v[4][4];
#pragma unroll
        for (int r = 0; r < 4; ++r) { const int row = r0 + r * GW, rr = row < NLAT ? row : r0; const float* xr = a.out + (size_t)rr * D;
#pragma unroll
            for (int i = 0; i < 4; ++i) v[r][i] = *(const f32x4*)(xr + lane * 4 + 256 * i); }
#pragma unroll
        for (int r = 0; r < 4; ++r) { const int row = r0 + r * GW; float ss = 0.f;
#pragma unroll
            for (int i = 0; i < 4; ++i) ss += v[r][i][0] * v[r][i][0] + v[r][i][1] * v[r][i][1] + v[r][i][2] * v[r][i][2] + v[r][i][3] * v[r][i][3];
            ss = wave_sum(ss); const float rstd = rsqrtf(ss * (1.f / 1024.f) + EPS);
            if (row < NLAT) {
#pragma unroll
                for (int i = 0; i < 4; ++i) { const f32x4 gg = *(const f32x4*)(g + lane * 4 + 256 * i); *(f32x4*)(a.out + (size_t)row * D + lane * 4 + 256 * i) = v[r][i] * rstd * gg; } } }
    }
}

constexpr int PER_LAYER = (PROBE_S >= 0 && PROBE_S < 9) ? 10 : 9;
constexpr int NPRE = (PROBE_S == 9) ? 2 : 1;
constexpr int NPHASE = NPRE + 2 * PER_LAYER + 1;
__global__ void __launch_bounds__(NTHREADS, 2) mk_fwd(Args a) {
    extern __shared__ __attribute__((aligned(16))) unsigned char lds_raw[];
    lptr lds = (lptr)lds_raw;
    cg::grid_group grid = cg::this_grid();
    const int G = gridDim.x;
    for (int ph = a.ph_lo; ph < a.ph_hi; ++ph) {
        if (ph > a.ph_lo) grid.sync();
        int tid = threadIdx.x, bid = blockIdx.x;
        asm volatile("" : "+v"(tid)); asm volatile("" : "+s"(bid));
        if (ph < NPRE) { phase_prep(a, lds, tid, bid); continue; }
        if (ph == NPHASE - 1) { phase_final(a, tid, bid); continue; }
        const int l = (ph - NPRE) / PER_LAYER, j = (ph - NPRE) % PER_LAYER, s = (PER_LAYER == 10 && j > PROBE_S) ? j - 1 : j;
        float* ctxres = (float*)(a.ws + WS_CTX);
        const bool orig = (l == 0 && s <= 5);
        const float* xlat = orig ? a.in[I_X] : a.out;
        const float* xctx = orig ? a.in[I_CTX] : ctxres;
        bf16_t* wt = (bf16_t*)(a.ws + WS_WT + (size_t)l * WT_LAYER);
        bf16_t* hb = (bf16_t*)(a.ws + WS_H);
        const float* mod = (const float*)(a.ws + WS_MOD) + (size_t)l * 9 * 6144;
        switch (s) {
        case 0: phase_norm(a, l, 0, NROW, xlat, xctx, lds, tid, bid); break;
        case 1: { pg8::Gemm g{hb, wt + WT_WIN / 2, NROW, NPROJ, D}; pg8::Order S; S.init(10, l == 0 ? 10 : 6, G, bid);
                  pg8::EpiBf16<0> E{(bf16_t*)(a.ws + WS_PROJ), NPROJ}; pg8::gemm_phase(lds, g, S, E, tid); } break;
        case 2: phase_conv(a, l, tid, bid); break;
        case 3: phase_scan(a, l, lds, tid, bid); break;
        case 4: phase_combine(a, l, l == 0 ? NROW : NLAT, tid, bid); break;
        case 5: { pg8::Gemm g{hb, wt + WT_WOUT / 2, NROW, D, D}; pg8::Order S; S.init(4, l == 0 ? 4 : 0, G, bid);
                  pg8::EpiGate E{xlat, a.out, xctx, ctxres, mod + 2048}; pg8::gemm_phase(lds, g, S, E, tid); } break;
        case 6: phase_norm(a, l, 1, l == 0 ? NROW : NLAT, a.out, ctxres, lds, tid, bid); break;
        case 7: { pg8::Gemm g{hb, wt + WT_W1 / 2, NROW, DFF, D}; pg8::Order S; S.init(16, l == 0 ? 16 : 0, G, bid);
                  pg8::EpiBf16<1> E{(bf16_t*)(a.ws + WS_HID), DFF}; pg8::gemm_phase(lds, g, S, E, tid); } break;
        case 8: { pg8::Gemm g{(const bf16_t*)(a.ws + WS_HID), wt + WT_W2 / 2, NROW, D, DFF}; pg8::Order S; S.init(4, l == 0 ? 4 : 0, G, bid);
                  pg8::EpiGate E{a.out, a.out, ctxres, ctxres, mod + 5120}; pg8::gemm_phase(lds, g, S, E, tid); } break;
        }
        __syncthreads();
    }
}

extern "C" void kernel_launch(void* const* d_in, const int* in_sizes, int n_in, void* d_out, int out_size, void* d_ws, size_t ws_size, hipStream_t stream) {
    static int grid = 0;
    if (grid == 0) {
        if (n_in != 26 || ws_size < WS_END) { fprintf(stderr, "kernel_launch: unexpected n_in %d / ws_size %zu\n", n_in, ws_size); grid = -1; return; }
        int dev = 0, cus = 0, per_cu = 0;
        if (hipGetDevice(&dev) != hipSuccess || hipDeviceGetAttribute(&cus, hipDeviceAttributeMultiprocessorCount, dev) != hipSuccess) { grid = -1; return; }
        if (hipFuncSetAttribute((const void*)mk_fwd, hipFuncAttributeMaxDynamicSharedMemorySize, LDS_BYTES) != hipSuccess) { fprintf(stderr, "kernel_launch: hipFuncSetAttribute failed\n"); grid = -1; return; }
        if (hipOccupancyMaxActiveBlocksPerMultiprocessor(&per_cu, (const void*)mk_fwd, NTHREADS, LDS_BYTES) != hipSuccess || per_cu < 1) { fprintf(stderr, "kernel_launch: occupancy query says %d\n", per_cu); per_cu = 1; }
        (void)hipGetLastError();
        grid = cus;
    }
    if (grid < 0) return;
    Args a{};
    for (int i = 0; i < 26; ++i) a.in[i] = (const float*)d_in[i];
    a.out = (float*)d_out; a.ws = (unsigned char*)d_ws;
#if ONE_LAUNCH
    a.ph_lo = 0; a.ph_hi = NPHASE;
    void* args[] = {&a};
    hipError_t e = hipLaunchCooperativeKernel((const void*)mk_fwd, dim3(grid), dim3(NTHREADS), args, LDS_BYTES, stream);
    if (e != hipSuccess) fprintf(stderr, "cooperative launch failed: %s (grid %d)\n", hipGetErrorString(e), grid);
#else
    for (int p = 0; p < NPHASE; ++p) { a.ph_lo = p; a.ph_hi = p + 1; hipLaunchKernelGGL(mk_fwd, dim3(grid), dim3(NTHREADS), LDS_BYTES, stream, a); }
#endif
}
```
